# Optimizing an MI355X kernel written in HIP

```python
import jax
import jax.numpy as jnp
from jax import lax
import numpy as np

D_MODEL = 1024
BATCH = 16
SEQ = 2048
DEPTH = 2
DEC_BATCH = 8
DEC_SEQ = 64
PAST_LEN = 2048

CHUNK = 64
N_META = 16
EPS = 1e-6

R_HEADS = 4
R_DK = 64
R_DV = 128
ROPE_BASE = 10000.0
M_HEADS = 4
M_DH = 128
CONV_W = 4
G_HEADS = 4
G_DK = 64
G_DV = 128
G_RANK = 16
G_NORMALIZER = 16.0

R_QK = R_HEADS * R_DK
R_V = R_HEADS * R_DV
M_W = M_HEADS * M_DH
G_QK = G_HEADS * G_DK
G_V = G_HEADS * G_DV
D_FF = ((-(-8 * D_MODEL // 3)) + 255) // 256 * 256
IN_WIDTHS = (R_QK, R_QK, R_V, R_V, M_W, M_W, M_HEADS, M_HEADS,
             G_QK, G_QK, G_V, G_V, G_RANK, D_MODEL, D_MODEL, D_MODEL)
D_IN = sum(IN_WIDTHS)

kernel_name = 'hybrid_streaming_retention_mlstm_gla_step'


def _rmsnorm(x, g):
    xf = x.astype(jnp.float32)
    y = xf * lax.rsqrt(jnp.mean(xf * xf, axis=-1, keepdims=True) + EPS)
    return (y * g.astype(jnp.float32)).astype(x.dtype)


def _head_norm(o):
    return o * lax.rsqrt(jnp.mean(o * o, axis=-1, keepdims=True) + EPS)


def _rotary(x, pos):
    half = x.shape[-1] // 2
    inv = 1.0 / (ROPE_BASE ** jnp.linspace(0.0, 1.0, half, dtype=jnp.float32))
    ang = pos[:, None] * inv[None, :]
    cos = jnp.cos(ang)[None, :, None, :]
    sin = jnp.sin(ang)[None, :, None, :]
    x1, x2 = x[..., :half], x[..., half:]
    return jnp.concatenate([x1 * cos - x2 * sin, x1 * sin + x2 * cos], axis=-1)


def _causal_conv(x, buf, w, b):
    T = x.shape[1]
    xc = jnp.concatenate([buf.astype(x.dtype), x], axis=1)
    y = b.astype(x.dtype) + sum(xc[:, j:j + T] * w[j].astype(x.dtype) for j in range(CONV_W))
    return y, xc[:, xc.shape[1] - (CONV_W - 1):]


def _gated_linear_chunk(q, k, v, log_a, s0, chunk):
    B, T, H, dk = q.shape
    dv = v.shape[-1]
    n = T // chunk
    q = q.reshape(B, n, chunk, H, dk)
    k = k.reshape(B, n, chunk, H, dk)
    v = v.reshape(B, n, chunk, H, dv)
    b = jnp.cumsum(log_a.reshape(B, n, chunk, H, dk), axis=2)
    b_last = b[:, :, -1]
    q_in = q * jnp.exp(b)
    k_in = k * jnp.exp(-b)
    k_st = k * jnp.exp(b_last[:, :, None] - b)
    mask = jnp.tril(jnp.ones((chunk, chunk), dtype=bool))
    scores = jnp.where(mask, jnp.einsum('bnthc,bnshc->bnhts', q_in, k_in), 0.0)
    o = jnp.einsum('bnhts,bnshv->bnthv', scores, v)
    ds = jnp.einsum('bnshc,bnshv->bnhcv', k_st, v)

    def step(s, inp):
        dec, d = inp
        return dec[..., None] * s + d, s

    s_fin, s_prev = lax.scan(step, s0, (jnp.moveaxis(jnp.exp(b_last), 1, 0), jnp.moveaxis(ds, 1, 0)))
    s_prev = jnp.moveaxis(s_prev, 0, 1)
    o = o + jnp.einsum('bnthc,bnhcv->bnthv', q_in, s_prev)
    return o.reshape(B, T, H, dv), s_fin


def _mlstm_chunk(q, k, v, ig, lf, state, chunk):
    c0, n0, m0 = state
    B, T, H, d = q.shape
    n = T // chunk
    q, k, v = (a.reshape(B, n, chunk, H, d) for a in (q, k, v))
    ig = ig.reshape(B, n, chunk, H)
    b = jnp.cumsum(lf.reshape(B, n, chunk, H), axis=2)
    a = ig - b
    g = lax.cummax(a, axis=2)
    b_last = b[:, :, -1]
    m_loc = b_last + g[:, :, -1]
    w_st = jnp.exp(a + (b_last - m_loc)[:, :, None])
    dc = jnp.einsum('bnsh,bnshk,bnshv->bnhkv', w_st, k, v)
    dn = jnp.einsum('bnsh,bnshk->bnhk', w_st, k)

    def step(carry, inp):
        c, nn, m = carry
        bl, ml, dci, dni = inp
        m_new = jnp.maximum(bl + m, ml)
        s_old = jnp.exp(bl + m - m_new)
        s_new = jnp.exp(ml - m_new)
        c_new = s_old[..., None, None] * c + s_new[..., None, None] * dci
        n_new = s_old[..., None] * nn + s_new[..., None] * dni
        return (c_new, n_new, m_new), (c, nn, m)

    mv = lambda t: jnp.moveaxis(t, 1, 0)
    (c_f, n_f, m_f), (c_p, n_p, m_p) = lax.scan(step, (c0, n0, m0), (mv(b_last), mv(m_loc), mv(dc), mv(dn)))
    c_p, n_p, m_p = (jnp.moveaxis(t, 0, 1) for t in (c_p, n_p, m_p))
    m_t = b + jnp.maximum(m_p[:, :, None], g)
    w_inter = jnp.exp(b + m_p[:, :, None] - m_t)
    log_d = jnp.swapaxes(b - m_t, 2, 3)[..., :, None] + jnp.swapaxes(a, 2, 3)[..., None, :]
    mask = jnp.tril(jnp.ones((chunk, chunk), dtype=bool))
    dmat = jnp.exp(jnp.where(mask, log_d, -jnp.inf))
    scores = jnp.einsum('bnthd,bnshd->bnhts', q, k) * dmat
    num = (jnp.einsum('bnhts,bnshv->bnthv', scores, v)
           + w_inter[..., None] * jnp.einsum('bnthk,bnhkv->bnthv', q, c_p))
    den = jnp.swapaxes(scores.sum(-1), 2, 3) + w_inter * jnp.einsum('bnthk,bnhk->bnth', q, n_p)
    h = num / jnp.maximum(jnp.abs(den), jnp.exp(-m_t))[..., None]
    return h.reshape(B, T, H, d), (c_f, n_f, m_f)


def _over_segments(fn, arrays, state, segs):
    outs, start = [], 0
    for length in segs:
        part = [a[:, start:start + length] for a in arrays]
        o, state = fn(*part, state, min(CHUNK, length))
        outs.append(o)
        start += length
    return jnp.concatenate(outs, axis=1), state


def _layer(x, pos, segs, st, w):
    s_ret, c_m, n_m, m_m, conv_buf, s_gla = st
    (norm1, w_in, b_i, b_f, conv_w, conv_b, w_mq, w_mk, w_mv, m_skip, w_a2, b_a,
     w_br_ret, w_br_mlstm, w_br_gla, w_out, norm2, w_ffn_in, w_ffn_out) = w
    f32 = jnp.float32
    B, T, _ = x.shape
    h = _rmsnorm(x, norm1)
    offs = tuple(int(o) for o in np.cumsum(IN_WIDTHS)[:-1])
    (rq, rk, rv, rg, mx, mz, mi, mf, gq, gk, gv, gr, ga,
     z_ret, z_mlstm, z_gla) = jnp.split(h @ w_in, offs, axis=-1)

    log_gamma = jnp.log(1.0 - 2.0 ** (-5.0 - jnp.arange(R_HEADS, dtype=f32)))
    rq_h = _rotary(rq.astype(f32).reshape(B, T, R_HEADS, R_DK), pos)
    rk_h = _rotary(rk.astype(f32).reshape(B, T, R_HEADS, R_DK), pos) * (R_DK ** -0.5)
    rv_h = rv.astype(f32).reshape(B, T, R_HEADS, R_DV)
    la_r = jnp.broadcast_to(log_gamma[None, None, :, None], rq_h.shape)
    o_r, s_ret = _over_segments(_gated_linear_chunk, (rq_h, rk_h, rv_h, la_r), s_ret.astype(f32), segs)
    o_r = _head_norm(o_r).reshape(B, T, R_V) * jax.nn.silu(rg.astype(f32))
    p_ret = o_r.astype(x.dtype) @ w_br_ret

    c_pre, conv_new = _causal_conv(mx, conv_buf, conv_w, conv_b)
    c = jax.nn.silu(c_pre.astype(f32))
    c_h = c.reshape(B, T, M_HEADS, M_DH)
    mq = jnp.einsum('bthd,hde->bthe', c_h, w_mq.astype(f32))
    mk = jnp.einsum('bthd,hde->bthe', c_h, w_mk.astype(f32)) * (M_DH ** -0.5)
    mvv = jnp.einsum('bthd,hde->bthe', mx.astype(f32).reshape(B, T, M_HEADS, M_DH), w_mv.astype(f32))
    ig = mi.astype(f32) + b_i.astype(f32)
    lf = jax.nn.log_sigmoid(mf.astype(f32) + b_f.astype(f32))
    h_m, (c_m, n_m, m_m) = _over_segments(
        _mlstm_chunk, (mq, mk, mvv, ig, lf),
        (c_m.astype(f32), n_m.astype(f32), m_m.astype(f32)), segs)
    o_m = jax.nn.sigmoid(mz.astype(f32)) * (_head_norm(h_m).reshape(B, T, M_W) + m_skip.astype(f32) * c)
    p_mlstm = o_m.astype(x.dtype) @ w_br_mlstm

    gq_h = gq.astype(f32).reshape(B, T, G_HEADS, G_DK) * (G_DK ** -0.5)
    gk_h = gk.astype(f32).reshape(B, T, G_HEADS, G_DK)
    gv_h = gv.astype(f32).reshape(B, T, G_HEADS, G_DV)
    la_g = (jax.nn.log_sigmoid((ga @ w_a2 + b_a).astype(f32)) / G_NORMALIZER).reshape(B, T, G_HEADS, G_DK)
    o_g, s_gla = _over_segments(_gated_linear_chunk, (gq_h, gk_h, gv_h, la_g), s_gla.astype(f32), segs)
    o_g = _head_norm(o_g).reshape(B, T, G_V) * jax.nn.silu(gr.astype(f32))
    p_gla = o_g.astype(x.dtype) @ w_br_gla

    sg = lambda z: jax.nn.sigmoid(z.astype(f32)).astype(x.dtype)
    mix = sg(z_ret) * p_ret + sg(z_mlstm) * p_mlstm + sg(z_gla) * p_gla
    x = x + mix @ w_out

    h2 = _rmsnorm(x, norm2)
    u_g, u_v = jnp.split(h2 @ w_ffn_in, 2, axis=-1)
    x = x + (jax.nn.silu(u_g) * u_v) @ w_ffn_out
    return x, (s_ret, c_m, n_m, m_m, conv_new, s_gla)


def _trunk(x, pos, segs, states, weights, norm_f):
    new = []
    for l in range(DEPTH):
        x, st = _layer(x, pos, segs, tuple(s[l] for s in states), tuple(w[l] for w in weights))
        new.append(st)
    stacked = tuple(jnp.stack([st[i] for st in new]) for i in range(6))
    return _rmsnorm(x, norm_f), stacked


def setup_inputs(seed: int = 0) -> dict:
    key = jax.random.key(seed)
    ks = jax.random.split(key, 32)
    nrm = lambda k, shape, s: jax.random.normal(k, shape, jnp.float32) * s
    return {
        'x_prompt': nrm(ks[0], (BATCH, SEQ, D_MODEL), 1.0),
        'x_sample': nrm(ks[1], (DEC_BATCH, DEC_SEQ, D_MODEL), 1.0),
        'state_ret': nrm(ks[2], (DEPTH, DEC_BATCH, R_HEADS, R_DK, R_DV), 0.3),
        'state_mlstm_c': nrm(ks[3], (DEPTH, DEC_BATCH, M_HEADS, M_DH, M_DH), 0.3),
        'state_mlstm_n': nrm(ks[4], (DEPTH, DEC_BATCH, M_HEADS, M_DH), 0.3),
        'state_mlstm_m': 1.0 + nrm(ks[5], (DEPTH, DEC_BATCH, M_HEADS), 0.5),
        'state_mlstm_conv': nrm(ks[6], (DEPTH, DEC_BATCH, CONV_W - 1, M_W), 1.0),
        'state_gla': nrm(ks[7], (DEPTH, DEC_BATCH, G_HEADS, G_DK, G_DV), 0.3),
        'meta_tokens': nrm(ks[8], (N_META, D_MODEL), 1.0),
        'norm1': 1.0 + nrm(ks[9], (DEPTH, D_MODEL), 0.01),
        'w_in': nrm(ks[10], (DEPTH, D_MODEL, D_IN), D_MODEL ** -0.5),
        'b_mlstm_i': nrm(ks[11], (DEPTH, M_HEADS), 0.1),
        'b_mlstm_f': jnp.linspace(3.0, 6.0, M_HEADS, dtype=jnp.float32)[None] + nrm(ks[12], (DEPTH, M_HEADS), 0.1),
        'conv_w': nrm(ks[13], (DEPTH, CONV_W, M_W), CONV_W ** -0.5),
        'conv_b': nrm(ks[14], (DEPTH, M_W), 0.01),
        'w_mq': nrm(ks[15], (DEPTH, M_HEADS, M_DH, M_DH), M_DH ** -0.5),
        'w_mk': nrm(ks[16], (DEPTH, M_HEADS, M_DH, M_DH), M_DH ** -0.5),
        'w_mv': nrm(ks[17], (DEPTH, M_HEADS, M_DH, M_DH), M_DH ** -0.5),
        'm_skip': 1.0 + nrm(ks[18], (DEPTH, M_W), 0.1),
        'w_gla_a2': nrm(ks[19], (DEPTH, G_RANK, G_QK), G_RANK ** -0.5),
        'b_gla_a': nrm(ks[20], (DEPTH, G_QK), 0.1),
        'w_br_ret': nrm(ks[21], (DEPTH, R_V, D_MODEL), R_V ** -0.5),
        'w_br_mlstm': nrm(ks[22], (DEPTH, M_W, D_MODEL), M_W ** -0.5),
        'w_br_gla': nrm(ks[23], (DEPTH, G_V, D_MODEL), G_V ** -0.5),
        'w_out': nrm(ks[24], (DEPTH, D_MODEL, D_MODEL), D_MODEL ** -0.5),
        'norm2': 1.0 + nrm(ks[25], (DEPTH, D_MODEL), 0.01),
        'w_ffn_in': nrm(ks[26], (DEPTH, D_MODEL, 2 * D_FF), D_MODEL ** -0.5),
        'w_ffn_out': nrm(ks[27], (DEPTH, D_FF, D_MODEL), D_FF ** -0.5),
        'norm_f': 1.0 + nrm(ks[28], (D_MODEL,), 0.01),
    }


def reference(x_prompt, x_sample, state_ret, state_mlstm_c, state_mlstm_n, state_mlstm_m,
              state_mlstm_conv, state_gla, meta_tokens, norm1, w_in, b_mlstm_i, b_mlstm_f,
              conv_w, conv_b, w_mq, w_mk, w_mv, m_skip, w_gla_a2, b_gla_a, w_br_ret,
              w_br_mlstm, w_br_gla, w_out, norm2, w_ffn_in, w_ffn_out, norm_f):
    f32 = jnp.float32
    weights = (norm1, w_in, b_mlstm_i, b_mlstm_f, conv_w, conv_b, w_mq, w_mk, w_mv, m_skip,
               w_gla_a2, b_gla_a, w_br_ret, w_br_mlstm, w_br_gla, w_out, norm2, w_ffn_in, w_ffn_out)

    B, S, _ = x_prompt.shape
    meta = jnp.broadcast_to(meta_tokens.astype(x_prompt.dtype)[None], (B, N_META, D_MODEL))
    xp = jnp.concatenate([meta, x_prompt], axis=1)
    pos_p = jnp.arange(N_META + S, dtype=f32)
    zeros = (jnp.zeros((DEPTH, B, R_HEADS, R_DK, R_DV), f32),
             jnp.zeros((DEPTH, B, M_HEADS, M_DH, M_DH), f32),
             jnp.zeros((DEPTH, B, M_HEADS, M_DH), f32),
             jnp.zeros((DEPTH, B, M_HEADS), f32),
             jnp.zeros((DEPTH, B, CONV_W - 1, M_W), x_prompt.dtype),
             jnp.zeros((DEPTH, B, G_HEADS, G_DK, G_DV), f32))
    yp, (p_ret, p_c, p_n, p_m, p_conv, p_gla) = _trunk(xp, pos_p, (N_META, S), zeros, weights, norm_f)
    y_prompt = yp[:, N_META:]

    T = x_sample.shape[1]
    pos_s = (N_META + PAST_LEN) + jnp.arange(T, dtype=f32)
    y_sample, (s_ret, s_c, s_n, s_m, s_conv, s_gla) = _trunk(
        x_sample, pos_s, (T,),
        (state_ret, state_mlstm_c, state_mlstm_n, state_mlstm_m, state_mlstm_conv, state_gla),
        weights, norm_f)
    return (y_prompt, y_sample, p_ret, p_c, p_n, p_m, p_conv, p_gla, s_ret, s_c, s_n, s_m, s_conv, s_gla)
```

```cpp
#include <hip/hip_runtime.h>
#include <hip/hip_cooperative_groups.h>
#include <cstdio>
#include <cstdint>
namespace cg = cooperative_groups;
namespace pg8 {
#define PG8_LAS __attribute__((address_space(3)))
typedef unsigned short bf16_t;
typedef short bf16x8 __attribute__((ext_vector_type(8)));
typedef float f32x4 __attribute__((ext_vector_type(4)));
typedef unsigned u32x4 __attribute__((ext_vector_type(4)));
constexpr int BM = 256, BK = 64, HALF = 128, HTB = HALF * BK * 2  , STAGE_BYTES = 8 * HTB, NXCD = 8, WGM = 8;

__host__ __device__ __forceinline__ int lds_byte(int r, int c) { const int st = (r >> 4) * 2 + (c >> 5), rr = r & 15, cc = c & 31, ob = rr * 64 + cc * 2; return st * 1024 + (ob ^ (((ob >> 9) & 1) << 5)); }
__host__ __device__ __forceinline__ void stage_rc(int b, int& R, int& C) { const int st = b / 1024, sb = b % 1024, swz = sb ^ (((sb >> 9) & 1) << 5); R = (st >> 1) * 16 + swz / 64; C = (st & 1) * 32 + (swz % 64) / 2; }
__host__ __device__ __forceinline__ int perm32(int rho) { const int n = rho >> 4, i = rho & 15; return 8 * (i >> 2) + 4 * n + (i & 3); }

struct Unit { int pm, pn; unsigned offA = 0u, offB = 0u; int z = 0; };
struct Gemm { const bf16_t* A; const bf16_t* Bt; int M, N, K; int ld = 0; };

struct StaticOrder {
    int nM, nN, nwg, G, c;
    __host__ __device__ void init(int M, int N, int G_, int c_) { nM = M / BM; nN = N / BM; nwg = nM * nN; G = G_; c = c_; }
    __host__ __device__ bool next(int i, Unit& u) const {
        const long L = (long)i * G + c; if (L >= nwg) return false;
        int wgid = (int)L; { const int q = nwg / NXCD, r = nwg % NXCD, xcd = wgid % NXCD, off = wgid / NXCD; wgid = (xcd < r ? xcd * (q + 1) : r * (q + 1) + (xcd - r) * q) + off; }
        const int nig = WGM * nN, gid = wgid / nig, fm = gid * WGM, gsz = (nM - fm) < WGM ? (nM - fm) : WGM;
        u.pm = fm + ((wgid % nig) % gsz); u.pn = (wgid % nig) / gsz; return true;
    }
    __device__ __forceinline__ void a_ready(const Unit&) const {}
    __device__ __forceinline__ void done(const Unit&) const {}
};

typedef float f32x2_cv __attribute__((ext_vector_type(2))); typedef __bf16 bf16x2_cv __attribute__((ext_vector_type(2)));
__device__ __forceinline__ unsigned cvt_pk_bf16(float lo, float hi) { const f32x2_cv v = {lo, hi}; const bf16x2_cv b = __builtin_convertvector(v, bf16x2_cv); return __builtin_bit_cast(unsigned, b); }
typedef float f32x2 __attribute__((ext_vector_type(2)));
template <class Epi, class Sched, bool ALIGN_EPI = false, bool SP2 = false>
__device__ __forceinline__ void gemm_phase(const int tid, PG8_LAS unsigned char* lds, const Gemm g, const Sched& S, const Epi& E) {
    const int wid = __builtin_amdgcn_readfirstlane(tid >> 6), lane = tid & 63, wr = wid >> 2, wc = wid & 3, fr = lane & 15, fq = lane >> 4;
    const int K = g.ld ? g.ld : g.K, nt = g.K / BK;
    unsigned voffA[2], voffB[2];
#pragma unroll
    for (int i = 0; i < 2; ++i) { int R, C; stage_rc(tid * 16 + i * 8192, R, C); const int Rb = Epi::PERM ? ((R & ~31) + perm32(R & 31)) : R;
        voffA[i] = (unsigned)(R * K + C) * 2u; voffB[i] = (unsigned)(Rb * K + C) * 2u; }
    const size_t kstep = (size_t)(BK * 2);
    const size_t hstep = (size_t)HALF * K * 2;
    const size_t tstep = 2 * hstep;
    const unsigned ldsw = (unsigned)wid * 1024u;
    const int aoff = lds_byte(wr * 64 + fr, fq * 8), boff = lds_byte(wc * 32 + fr, fq * 8);
#define PG8_SA(b, h) (((b) * 2 + (h)) * HTB)
#define PG8_SB(b, h) ((4 + (b) * 2 + (h)) * HTB)
#define PG8_STAGE(bufoff, gbase, voff) do { _Pragma("unroll") for (int _i = 0; _i < 2; ++_i) \
        __builtin_amdgcn_global_load_lds((const unsigned*)((const char*)(gbase) + (voff)[_i]), (PG8_LAS unsigned*)(lds + (bufoff) + ldsw + _i * 8192), 16, 0, 0); } while (0)
#define PG8_LDA(dst, b, h) do { _Pragma("unroll") for (int m = 0; m < 4; ++m) _Pragma("unroll") for (int k = 0; k < 2; ++k) dst[m][k] = *(const PG8_LAS bf16x8*)(lds + PG8_SA(b, h) + aoff + m * 2048 + k * 1024); } while (0)
#define PG8_LDB(dst, b, h) do { _Pragma("unroll") for (int n = 0; n < 2; ++n) _Pragma("unroll") for (int k = 0; k < 2; ++k) dst[n][k] = *(const PG8_LAS bf16x8*)(lds + PG8_SB(b, h) + boff + n * 2048 + k * 1024); } while (0)
#define PG8_MMA(ai, bj, At, Bt) do { __builtin_amdgcn_s_setprio(1); _Pragma("unroll") for (int m = 0; m < 4; ++m) _Pragma("unroll") for (int n = 0; n < 2; ++n) _Pragma("unroll") for (int k = 0; k < 2; ++k) \
        acc[ai][bj][m][n] = __builtin_amdgcn_mfma_f32_16x16x32_bf16(Bt[n][k], At[m][k], acc[ai][bj][m][n], 0, 0, 0); __builtin_amdgcn_s_setprio(0); } while (0)
#define PG8_WAIT_V(n) asm volatile("s_waitcnt vmcnt(" #n ")" ::: "memory")
#define PG8_WAIT_L(n) asm volatile("s_waitcnt lgkmcnt(" #n ")" ::: "memory")
#define PG8_BAR __builtin_amdgcn_s_barrier()
#define PG8_SCHED __builtin_amdgcn_sched_barrier(0)
    Unit cur, nxt; int ui = 0;
    if (!S.next(0, cur)) return;
    f32x4 acc[2][2][4][2];
#pragma unroll
    for (int a = 0; a < 2; ++a)
#pragma unroll
        for (int b = 0; b < 2; ++b)
#pragma unroll
            for (int m = 0; m < 4; ++m)
#pragma unroll
                for (int n = 0; n < 2; ++n) acc[a][b][m][n] = (f32x4){0.f, 0.f, 0.f, 0.f};
    bf16x8 At[4][2], B0[2][2], B1[2][2];
    const char* cA = (const char*)g.A + (size_t)cur.pm * tstep + cur.offA; const char* cB = (const char*)g.Bt + (size_t)cur.pn * tstep + cur.offB;
    S.a_ready(cur);
    if constexpr (SP2) {
        PG8_STAGE(PG8_SB(0, 0), cB, voffB); PG8_STAGE(PG8_SB(0, 1), cB + hstep, voffB); PG8_STAGE(PG8_SA(0, 0), cA, voffA); PG8_STAGE(PG8_SA(0, 1), cA + hstep, voffA);
        if (wr == 1) PG8_BAR;
        PG8_WAIT_V(2); PG8_BAR;
        PG8_STAGE(PG8_SB(1, 0), cB + kstep, voffB); PG8_STAGE(PG8_SA(1, 0), cA + kstep, voffA); PG8_STAGE(PG8_SB(1, 1), cB + hstep + kstep, voffB);
        PG8_WAIT_V(6); PG8_BAR;
    } else {
        PG8_STAGE(PG8_SB(0, 0), cB, voffB); PG8_STAGE(PG8_SA(0, 0), cA, voffA); PG8_STAGE(PG8_SB(0, 1), cB + hstep, voffB); PG8_STAGE(PG8_SA(0, 1), cA + hstep, voffA);
        if (wr == 1) PG8_BAR;
        PG8_WAIT_V(4); PG8_BAR;
        PG8_STAGE(PG8_SB(1, 0), cB + kstep, voffB); PG8_STAGE(PG8_SA(1, 0), cA + kstep, voffA); PG8_STAGE(PG8_SB(1, 1), cB + hstep + kstep, voffB);
        PG8_WAIT_V(6); PG8_BAR;
    }
    for (;;) {
        const bool has_next = S.next(ui + 1, nxt);
        const char* nA = has_next ? (const char*)g.A + (size_t)nxt.pm * tstep + nxt.offA : cA; const char* nB = has_next ? (const char*)g.Bt + (size_t)nxt.pn * tstep + nxt.offB : cB;
        for (int t = 0; t < nt; t += 2) {
            const bool last = (t == nt - 2);
            const char* a1 = cA + (size_t)(t + 1) * kstep;
            const char* a2 = last ? nA : cA + (size_t)(t + 2) * kstep; const char* b2 = last ? nB : cB + (size_t)(t + 2) * kstep;
            const char* a3 = a2 + kstep; const char* b3 = b2 + kstep;
            if (last && has_next) S.a_ready(nxt);
            if constexpr (SP2) {
            PG8_LDB(B0, 0, 0); PG8_LDB(B1, 0, 1); PG8_SCHED; PG8_LDA(At, 0, 0); PG8_STAGE(PG8_SA(1, 1), a1 + hstep, voffA);
            PG8_WAIT_V(8); PG8_WAIT_L(0); PG8_BAR; PG8_MMA(0, 0, At, B0); PG8_MMA(0, 1, At, B1); PG8_BAR; PG8_SCHED;
            PG8_LDA(At, 0, 1); PG8_STAGE(PG8_SB(0, 0), b2, voffB); PG8_STAGE(PG8_SB(0, 1), b2 + hstep, voffB); PG8_STAGE(PG8_SA(0, 0), a2, voffA);
            PG8_WAIT_V(8); PG8_WAIT_L(0); PG8_BAR; PG8_MMA(1, 0, At, B0); PG8_MMA(1, 1, At, B1); PG8_BAR; PG8_SCHED;
            PG8_LDB(B0, 1, 0); PG8_LDB(B1, 1, 1); PG8_SCHED; PG8_LDA(At, 1, 0); PG8_STAGE(PG8_SA(0, 1), a2 + hstep, voffA);
            PG8_WAIT_V(8); PG8_WAIT_L(0); PG8_BAR; PG8_MMA(0, 0, At, B0); PG8_MMA(0, 1, At, B1); PG8_BAR; PG8_SCHED;
            PG8_LDA(At, 1, 1); PG8_STAGE(PG8_SB(1, 0), b3, voffB); PG8_STAGE(PG8_SB(1, 1), b3 + hstep, voffB); PG8_STAGE(PG8_SA(1, 0), a3, voffA);
            PG8_WAIT_V(8); PG8_WAIT_L(0); PG8_BAR; PG8_MMA(1, 0, At, B0); PG8_MMA(1, 1, At, B1); PG8_BAR; PG8_SCHED;
            } else {
            PG8_LDB(B0, 0, 0); PG8_SCHED; PG8_LDA(At, 0, 0); PG8_STAGE(PG8_SA(1, 1), a1 + hstep, voffA);
            PG8_WAIT_L(8); PG8_BAR; PG8_WAIT_L(0); PG8_MMA(0, 0, At, B0); PG8_BAR; PG8_SCHED;
            PG8_LDB(B1, 0, 1); PG8_STAGE(PG8_SB(0, 0), b2, voffB);
            PG8_BAR; PG8_WAIT_L(0); PG8_MMA(0, 1, At, B1); PG8_BAR;
            PG8_LDA(At, 0, 1); PG8_STAGE(PG8_SA(0, 0), a2, voffA);
            PG8_BAR; PG8_WAIT_L(0); PG8_MMA(1, 0, At, B0); PG8_BAR; PG8_SCHED;
            PG8_STAGE(PG8_SB(0, 1), b2 + hstep, voffB);
            PG8_WAIT_V(6); PG8_BAR; PG8_MMA(1, 1, At, B1); PG8_BAR;
            PG8_LDB(B0, 1, 0); PG8_SCHED; PG8_LDA(At, 1, 0); PG8_STAGE(PG8_SA(0, 1), a2 + hstep, voffA);
            PG8_WAIT_L(8); PG8_BAR; PG8_WAIT_L(0); PG8_MMA(0, 0, At, B0); PG8_BAR; PG8_SCHED;
            PG8_LDB(B1, 1, 1); PG8_STAGE(PG8_SB(1, 0), b3, voffB);
            PG8_BAR; PG8_WAIT_L(0); PG8_MMA(0, 1, At, B1); PG8_BAR;
            PG8_LDA(At, 1, 1); PG8_STAGE(PG8_SA(1, 0), a3, voffA);
            PG8_BAR; PG8_WAIT_L(0); PG8_MMA(1, 0, At, B0); PG8_BAR; PG8_SCHED;
            PG8_STAGE(PG8_SB(1, 1), b3 + hstep, voffB);
            PG8_WAIT_V(6); PG8_BAR; PG8_MMA(1, 1, At, B1); PG8_BAR;
            }
        }
        if constexpr (ALIGN_EPI) { if (wr == 0) PG8_BAR; }
        if constexpr (!Epi::AFTER_DRAIN) { E(acc, cur, wr, wc, fr, fq); S.done(cur); }
        if (!has_next) break;
#pragma unroll
        for (int a = 0; a < 2; ++a)
#pragma unroll
            for (int b = 0; b < 2; ++b)
#pragma unroll
                for (int m = 0; m < 4; ++m)
#pragma unroll
                    for (int n = 0; n < 2; ++n) acc[a][b][m][n] = (f32x4){0.f, 0.f, 0.f, 0.f};
        cur = nxt; cA = nA; cB = nB; ++ui;
        if constexpr (ALIGN_EPI) { if (wr == 1) PG8_BAR; }
    }
    PG8_WAIT_V(0);
    if constexpr (!ALIGN_EPI) { if (wr == 0) PG8_BAR; }
    PG8_BAR;
    if constexpr (Epi::AFTER_DRAIN) { E.fused(acc, cur, wr, wc, fr, fq, lds, wid, lane); S.done(cur); }
#undef PG8_SA
#undef PG8_SB
#undef PG8_STAGE
#undef PG8_LDA
#undef PG8_LDB
#undef PG8_MMA
#undef PG8_WAIT_V
#undef PG8_WAIT_L
#undef PG8_BAR
#undef PG8_SCHED
}
}

#define DI __device__ __forceinline__
#define LAS __attribute__((address_space(3)))
typedef unsigned short bf16_t;
typedef short bf16x8 __attribute__((ext_vector_type(8)));
typedef float f32x4 __attribute__((ext_vector_type(4)));
typedef float f32x16 __attribute__((ext_vector_type(16)));
typedef unsigned u32x4 __attribute__((ext_vector_type(4)));
typedef unsigned u32x2 __attribute__((ext_vector_type(2)));
using pg8::cvt_pk_bf16;

constexpr int D = 1024, NIN = 7168, DFF = 2816, DIN_SRC = 7192;
constexpr int MTOT = 33536, G0ROWS = 8960, GROWS = 8192, NGROUP = 4;
constexpr int NTHREADS = 512;
constexpr float EPS = 1e-6f;
constexpr int LDS_BYTES = 147456;

constexpr size_t WS_X = 0;
constexpr size_t WS_XN = WS_X + (size_t)MTOT * D * 4;
constexpr size_t WS_W = WS_XN + (size_t)MTOT * D * 2;
constexpr size_t WL_WIN = 0, WL_WBR = 7340032, WL_WOUT = 8912896, WL_WFI = 9961472, WL_WFO = 15728640, WL_WM = 18612224, WL_WSM = 18808832, WL_END = 18874368;
constexpr size_t WS_SM = WS_W + 2 * WL_END * 2;
constexpr size_t WS_ROT = WS_SM + (size_t)MTOT * 32 * 4;
constexpr size_t WS_TS = WS_ROT + 2128 * 32 * 8;
constexpr size_t WS_DECG = WS_TS + (size_t)G0ROWS * 64;
constexpr size_t WS_MCH = WS_DECG + 137 * 256 * 4;
constexpr size_t WS_DN = WS_MCH + 137 * 8 * 4 + 32;
constexpr size_t WS_NP = WS_DN + 137 * 512 * 4;
constexpr size_t WS_MP = WS_NP + 137 * 512 * 4;
constexpr size_t WS_BAR = ((WS_MP + 137 * 16 + 4095) / 4096) * 4096;
constexpr size_t WS_G = WS_BAR + 16384;
constexpr size_t WS_PART = WS_G + (size_t)MTOT * DFF * 2;
constexpr int MMAIN = 32768, NKSL = 11;
constexpr size_t WS_END = WS_PART + (size_t)NKSL * (MTOT - MMAIN) * 1024 * 4;
static_assert(WS_END <= 536870912ull, "ws map");
static_assert((size_t)10240 * G0ROWS * 2 <= (size_t)MTOT * DFF * 2, "group region inside HB overlay");
constexpr int CP_QINR = 0, CP_KINR = 256, CP_KSTR = 512, CP_RV = 768, CP_RG = 1280, CP_MX = 1792, CP_MZ = 2304, CP_GQ = 2816, CP_GK = 3072, CP_GV = 3328, CP_GR = 3840,
              CP_ZG = 4352, CP_KSTG = 7424, CP_CC = 7680, CP_MQ = 8192, CP_MK = 8704, CP_MKST = 9216, CP_MV = 9728;
constexpr size_t O_YP = 0, O_YS = O_YP + 33554432, O_PRET = O_YS + 524288, O_PC = O_PRET + 1048576, O_PN = O_PC + 2097152, O_PM = O_PN + 16384, O_PCONV = O_PM + 128,
                 O_PGLA = O_PCONV + 49152, O_SRET = O_PGLA + 1048576, O_SC = O_SRET + 524288, O_SN = O_SC + 1048576, O_SMM = O_SN + 8192, O_SCONV = O_SMM + 64, O_SGLA = O_SCONV + 24576,
                 O_END = O_SGLA + 524288;
constexpr size_t DS_SPR = 0;
constexpr size_t DS_SPG = DS_SPR + (size_t)137 * 4 * 128 * 64 * 2;
constexpr size_t DS_SPM = DS_SPG + (size_t)137 * 4 * 128 * 64 * 2;
constexpr size_t DS_OB = DS_SPM + (size_t)137 * 4 * 128 * 128 * 2;
constexpr size_t DS_MIXF = DS_OB + (size_t)3 * G0ROWS * 512 * 2;
constexpr size_t DS_MIXB = DS_MIXF + (size_t)G0ROWS * 1024 * 4;
static_assert(DS_MIXB + (size_t)G0ROWS * 1024 * 2 <= (size_t)33554432 * 4, "d_out scratch");

struct Params { const float* in[29]; float* out; unsigned char* ws; int lo, hi; };
#define PARAMS const __attribute__((address_space(4))) Params&
__device__ __forceinline__ int tid_opaque() { int t = threadIdx.x; asm volatile("" : "+v"(t)); return t; }
#define TIDV tid_opaque()
__device__ __forceinline__ int bid_opaque() { int t = blockIdx.x; asm volatile("" : "+s"(t)); return t; }
__device__ __forceinline__ int gdim_opaque() { int t = gridDim.x; asm volatile("" : "+s"(t)); return t; }
#define BIDX bid_opaque()
#define GDIM gdim_opaque()

DI float bf2f(bf16_t v) { return __uint_as_float((unsigned)v << 16); }
DI bf16_t f2bf(float f) { return (bf16_t)cvt_pk_bf16(f, 0.f); }
DI float sigm(float x) { return __builtin_amdgcn_rcpf(1.f + __expf(-x)); }
DI float silu(float x) { return x * sigm(x); }
DI float logsig(float x) { return fminf(x, 0.f) - log1pf(__expf(-fabsf(x))); }
DI float wave_sum(float v) {
    v += __builtin_bit_cast(float, __builtin_amdgcn_update_dpp(0, __builtin_bit_cast(int, v), 0xB1, 0xF, 0xF, true));
    v += __builtin_bit_cast(float, __builtin_amdgcn_update_dpp(0, __builtin_bit_cast(int, v), 0x4E, 0xF, 0xF, true));
    v += __builtin_bit_cast(float, __builtin_amdgcn_update_dpp(0, __builtin_bit_cast(int, v), 0x141, 0xF, 0xF, true));
    v += __builtin_bit_cast(float, __builtin_amdgcn_update_dpp(0, __builtin_bit_cast(int, v), 0x140, 0xF, 0xF, true));
    const int b = __builtin_bit_cast(int, v);
    return (__builtin_bit_cast(float, __builtin_amdgcn_readlane(b, 0)) + __builtin_bit_cast(float, __builtin_amdgcn_readlane(b, 16))) +
           (__builtin_bit_cast(float, __builtin_amdgcn_readlane(b, 32)) + __builtin_bit_cast(float, __builtin_amdgcn_readlane(b, 48)));
}
DI int gbase(int g) { return g == 0 ? 0 : G0ROWS + (g - 1) * GROWS; }
DI int grows(int g) { return g == 0 ? G0ROWS : GROWS; }
DI int crow(int i, int hh) { return (i & 3) + 8 * (i >> 2) + 4 * hh; }
#define MFMA32(a, b, c) __builtin_amdgcn_mfma_f32_32x32x16_bf16((a), (b), (c), 0, 0, 0)
DI void row_info(int g, int lr, int& pos, int& jc, int& L) {
    if (g != 0 || lr < 8192) { const int t = lr & 2047; pos = 16 + t; jc = t & 63; L = 64; }
    else if (lr < 8704) { const int t = (lr - 8192) & 63; pos = 2064 + t; jc = t; L = 64; }
    else { const int t = lr - 8704; pos = t < 16 ? t : 0; jc = t & 63; L = 16; }
}
DI float lg2gamma(int h) { return log2f(1.0f - exp2f(-5.0f - (float)h)); }

using pg8::Unit;
template <int ACT> DI f32x4 act4(f32x4 v) {
    f32x4 o;
#pragma unroll
    for (int j = 0; j < 4; ++j) { const float x = v[j]; o[j] = ACT == 1 ? silu(x) : (ACT == 2 ? sigm(x) : (ACT == 3 ? x * 0.125f : x)); }
    return o;
}
DI u32x4 pack8(f32x4 a, f32x4 b) { u32x4 w; w.x = cvt_pk_bf16(a[0], a[1]); w.y = cvt_pk_bf16(a[2], a[3]); w.z = cvt_pk_bf16(b[0], b[1]); w.w = cvt_pk_bf16(b[2], b[3]); return w; }
DI void unpack8(u32x4 w, f32x4& a, f32x4& b) {
    a[0] = __uint_as_float(w.x << 16); a[1] = __uint_as_float(w.x & 0xffff0000u); a[2] = __uint_as_float(w.y << 16); a[3] = __uint_as_float(w.y & 0xffff0000u);
    b[0] = __uint_as_float(w.z << 16); b[1] = __uint_as_float(w.z & 0xffff0000u); b[2] = __uint_as_float(w.w << 16); b[3] = __uint_as_float(w.w & 0xffff0000u);
}

#ifndef EPI_ROT
#define EPI_ROT 1
#endif
struct EpiIn {
    static constexpr bool PERM = true, AFTER_DRAIN = false;
    bf16_t* gb; const float* rot; int g;
    DI void operator()(const f32x4 (&acc)[2][2][4][2], const Unit& u, int wr, int wc, int fr, int fq) const {
        const int pn = u.pn, rowb = u.pm * 256 + wr * 64 + fr;
        if (pn <= 1 && EPI_ROT) {
            const float lg = lg2gamma(wc);
#pragma unroll
            for (int ai = 0; ai < 2; ++ai)
#pragma unroll
                for (int m = 0; m < 4; ++m) {
                    int row = rowb + ai * 128 + m * 16; asm volatile("" : "+v"(row));
                    int pos, jc, L; row_info(g, row, pos, jc, L);
                    const f32x4* rp = (const f32x4*)(rot + ((size_t)pos * 32 + 8 * fq) * 2);
                    const float e1 = exp2f((float)(jc + 1) * lg);
                    const float sa = pn == 0 ? e1 : 0.125f / e1, sb = (g == 0 && row >= 8720) ? 0.f : 0.125f * exp2f((float)(L - 1 - jc) * lg);
                    bf16_t* d0 = gb + (size_t)(pn == 0 ? CP_QINR : CP_KINR) * G0ROWS + (size_t)row * 256 + wc * 64 + 8 * fq;
                    bf16_t* d1 = gb + (size_t)CP_KSTR * G0ROWS + (size_t)row * 256 + wc * 64 + 8 * fq;
#pragma unroll
                    for (int n = 0; n < 2; ++n) {
                        const f32x4 cs0 = rp[2 * n], cs1 = rp[2 * n + 1];
                        const f32x4 x1 = acc[ai][0][m][n], x2 = acc[ai][1][m][n];
                        f32x4 o1, o2;
                        o1[0] = x1[0] * cs0[0] - x2[0] * cs0[1]; o2[0] = x1[0] * cs0[1] + x2[0] * cs0[0];
                        o1[1] = x1[1] * cs0[2] - x2[1] * cs0[3]; o2[1] = x1[1] * cs0[3] + x2[1] * cs0[2];
                        o1[2] = x1[2] * cs1[0] - x2[2] * cs1[1]; o2[2] = x1[2] * cs1[1] + x2[2] * cs1[0];
                        o1[3] = x1[3] * cs1[2] - x2[3] * cs1[3]; o2[3] = x1[3] * cs1[3] + x2[3] * cs1[2];
                        u32x2 w; w.x = cvt_pk_bf16(o1[0] * sa, o1[1] * sa); w.y = cvt_pk_bf16(o1[2] * sa, o1[3] * sa); *(u32x2*)(d0 + 4 * n) = w;
                        w.x = cvt_pk_bf16(o2[0] * sa, o2[1] * sa); w.y = cvt_pk_bf16(o2[2] * sa, o2[3] * sa); *(u32x2*)(d0 + 32 + 4 * n) = w;
                        if (pn == 1) {
                            w.x = cvt_pk_bf16(o1[0] * sb, o1[1] * sb); w.y = cvt_pk_bf16(o1[2] * sb, o1[3] * sb); *(u32x2*)(d1 + 4 * n) = w;
                            w.x = cvt_pk_bf16(o2[0] * sb, o2[1] * sb); w.y = cvt_pk_bf16(o2[2] * sb, o2[3] * sb); *(u32x2*)(d1 + 32 + 4 * n) = w;
                        }
                    }
                    asm volatile("" ::: "memory");
                }
            return;
        }
        int W, cp, c0, act;
        if (pn < 4) { cp = CP_RV; W = 512; c0 = (pn - 2) * 256; act = 0; }
        else if (pn < 6) { cp = CP_RG; W = 512; c0 = (pn - 4) * 256; act = 1; }
        else if (pn < 8) { cp = CP_MX; W = 512; c0 = (pn - 6) * 256; act = 0; }
        else if (pn < 10) { cp = CP_MZ; W = 512; c0 = (pn - 8) * 256; act = 2; }
        else if (pn == 10) { cp = CP_GQ; W = 256; c0 = 0; act = 3; }
        else if (pn == 11) { cp = CP_GK; W = 256; c0 = 0; act = 0; }
        else if (pn < 14) { cp = CP_GV; W = 512; c0 = (pn - 12) * 256; act = 0; }
        else if (pn < 16) { cp = CP_GR; W = 512; c0 = (pn - 14) * 256; act = 1; }
        else { cp = CP_ZG; W = 3072; c0 = (pn - 16) * 256; act = 2; }
        bf16_t* base = gb + (size_t)cp * G0ROWS + c0 + wc * 32 + 8 * fq;
        const int row0 = rowb;
        if (act == 0) store_tile<0>(acc, base, row0, W); else if (act == 1) store_tile<1>(acc, base, row0, W); else if (act == 2) store_tile<2>(acc, base, row0, W); else store_tile<3>(acc, base, row0, W);
    }
    template <int ACT> DI static void store_tile(const f32x4 (&acc)[2][2][4][2], bf16_t* base, int rowb, int W) {
#pragma unroll
        for (int ai = 0; ai < 2; ++ai)
#pragma unroll
            for (int m = 0; m < 4; ++m) {
                bf16_t* rp = base + (size_t)(rowb + ai * 128 + m * 16) * W;
#pragma unroll
                for (int bj = 0; bj < 2; ++bj) *(u32x4*)(rp + bj * 128) = pack8(act4<ACT>(acc[ai][bj][m][0]), act4<ACT>(acc[ai][bj][m][1]));
                asm volatile("" ::: "memory");
            }
    }
};

struct BrOrder {
    pg8::StaticOrder S;
    DI bool next(int i, Unit& u) const { if (!S.next(i / 3, u)) return false; const int z = i % 3; u.z = z; u.offA = (unsigned)z * (unsigned)(G0ROWS * 512 * 2); u.offB = (unsigned)z * (unsigned)(524288 * 2); return true; }
    DI void a_ready(const Unit&) const {}
    DI void done(const Unit&) const {}
};
struct EpiBr {
    static constexpr bool PERM = true, AFTER_DRAIN = false;
    const bf16_t* zg0; float* mixf; bf16_t* mixb;
    DI void operator()(const f32x4 (&acc)[2][2][4][2], const Unit& u, int wr, int wc, int fr, int fq) const {
        const int mode = u.z; const bf16_t* zg = zg0 + mode * 1024;
        const int rowb = u.pm * 256 + wr * 64 + fr, colb = u.pn * 256 + wc * 32 + 8 * fq;
#pragma unroll
        for (int ai = 0; ai < 2; ++ai) {
            u32x4 zr[4][2], mr[4][2];
#pragma unroll
            for (int m = 0; m < 4; ++m)
#pragma unroll
                for (int bj = 0; bj < 2; ++bj) { const int row = rowb + ai * 128 + m * 16, col = colb + bj * 128;
                    zr[m][bj] = *(const u32x4*)(zg + (size_t)row * 3072 + col);
                    if (mode != 0) mr[m][bj] = *(const u32x4*)(mixb + (size_t)row * 1024 + col); else mr[m][bj] = (u32x4){0u, 0u, 0u, 0u}; }
#pragma unroll
            for (int m = 0; m < 4; ++m)
#pragma unroll
                for (int bj = 0; bj < 2; ++bj) { const int row = rowb + ai * 128 + m * 16, col = colb + bj * 128;
                    f32x4 z0, z1, p0, p1; unpack8(zr[m][bj], z0, z1); unpack8(mr[m][bj], p0, p1);
                    const f32x4 v0 = acc[ai][bj][m][0] * z0 + p0, v1 = acc[ai][bj][m][1] * z1 + p1;
                    *(u32x4*)(mixb + (size_t)row * 1024 + col) = pack8(v0, v1); }
        }
    }
};

struct EpiRes {
    static constexpr bool PERM = true, AFTER_DRAIN = false;
    float* x;
    DI void operator()(const f32x4 (&acc)[2][2][4][2], const Unit& u, int wr, int wc, int fr, int fq) const {
        const int rowb = u.pm * 256 + wr * 64 + fr, colb = u.pn * 256 + wc * 32 + 8 * fq;
#pragma unroll
        for (int aq = 0; aq < 4; ++aq) {
            const int ai = aq >> 1, m0 = (aq & 1) * 2;
            f32x4 pre[4][2][2];
#pragma unroll
            for (int m = m0; m < m0 + 2; ++m)
#pragma unroll
                for (int bj = 0; bj < 2; ++bj) { const f32x4* p = (const f32x4*)(x + (size_t)(rowb + ai * 128 + m * 16) * 1024 + colb + bj * 128); pre[m][bj][0] = p[0]; pre[m][bj][1] = p[1]; }
#pragma unroll
            for (int m = m0; m < m0 + 2; ++m)
#pragma unroll
                for (int bj = 0; bj < 2; ++bj) { f32x4* p = (f32x4*)(x + (size_t)(rowb + ai * 128 + m * 16) * 1024 + colb + bj * 128); p[0] = pre[m][bj][0] + acc[ai][bj][m][0]; p[1] = pre[m][bj][1] + acc[ai][bj][m][1]; }
        }
    }
};

struct TailOrder {
    int G, c;
    DI bool next(int i, Unit& u) const { const int j = i * G + c; if (j >= 3 * 4 * NKSL) return false; u.pm = MMAIN / 256 + j / (4 * NKSL); u.pn = (j / NKSL) & 3; const int kh = j % NKSL; u.z = kh; u.offA = (unsigned)(kh * 512); u.offB = (unsigned)(kh * 512); return true; }
    DI void a_ready(const Unit&) const {}
    DI void done(const Unit&) const {}
};
struct EpiPart {
    static constexpr bool PERM = true, AFTER_DRAIN = false;
    float* part;
    DI void operator()(const f32x4 (&acc)[2][2][4][2], const Unit& u, int wr, int wc, int fr, int fq) const {
        const int rowb = u.pm * 256 - MMAIN + wr * 64 + fr, colb = u.pn * 256 + wc * 32 + 8 * fq;
        float* pb = part + (size_t)u.z * (MTOT - MMAIN) * 1024;
#pragma unroll
        for (int ai = 0; ai < 2; ++ai)
#pragma unroll
            for (int m = 0; m < 4; ++m)
#pragma unroll
                for (int bj = 0; bj < 2; ++bj) { f32x4* p = (f32x4*)(pb + (size_t)(rowb + ai * 128 + m * 16) * 1024 + colb + bj * 128); p[0] = acc[ai][bj][m][0]; p[1] = acc[ai][bj][m][1]; }
    }
};

struct EpiSwiglu {
    static constexpr bool PERM = true, AFTER_DRAIN = false;
    bf16_t* hb;
    DI void operator()(const f32x4 (&acc)[2][2][4][2], const Unit& u, int wr, int wc, int fr, int fq) const {
        const int rowb = u.pm * 256 + wr * 64 + fr, colb = u.pn * 128 + wc * 32 + 8 * fq;
#pragma unroll
        for (int ai = 0; ai < 2; ++ai)
#pragma unroll
            for (int m = 0; m < 4; ++m) {
                f32x4 o[2];
#pragma unroll
                for (int n = 0; n < 2; ++n)
#pragma unroll
                    for (int j = 0; j < 4; ++j) o[n][j] = silu(acc[ai][0][m][n][j]) * acc[ai][1][m][n][j];
                *(u32x4*)(hb + (size_t)(rowb + ai * 128 + m * 16) * DFF + colb) = pack8(o[0], o[1]);
            }
    }
};

DI void tr_item(const float* W, int ldw, int K, int k0, int srccol0, bf16_t* WT, int dstrow0, LAS float* scr, int lane) {
#pragma unroll 8
    for (int i = 0; i < 32; ++i) { const int kk = 2 * i + (lane >> 5); scr[kk * 33 + (lane & 31)] = W[(size_t)(k0 + kk) * ldw + srccol0 + (lane & 31)]; }
    asm volatile("s_waitcnt lgkmcnt(0)" ::: "memory");
    const int c = lane & 7;
#pragma unroll
    for (int j = 0; j < 4; ++j) { const int n = (lane >> 3) + 8 * j; const LAS float* s = scr + (8 * c) * 33 + n;
        u32x4 o; o.x = cvt_pk_bf16(s[0 * 33], s[1 * 33]); o.y = cvt_pk_bf16(s[2 * 33], s[3 * 33]); o.z = cvt_pk_bf16(s[4 * 33], s[5 * 33]); o.w = cvt_pk_bf16(s[6 * 33], s[7 * 33]);
        *(u32x4*)(WT + (size_t)(dstrow0 + n) * K + k0 + 8 * c) = o; }
    asm volatile("s_waitcnt lgkmcnt(0)" ::: "memory");
}
DI int win_src(int n) {
    if (n < 512) { const int tile = n >> 8, p = n & 255, a = (p & 127) >> 5, half = p >> 7; return tile * 256 + a * 64 + half * 32; }
    if (n < 2560) return n;
    if (n < 4096) return n + 8;
    return n + 24;
}
DI int wfi_src(int n) { const int pn = n >> 8, p = n & 255; return p < 128 ? 128 * pn + p : DFF + 128 * pn + (p - 128); }

DI void prologue(PARAMS P, LAS unsigned char* lds, int wave, int lane) {
    const int gw = BIDX * 8 + wave, NGW = GDIM * 8, gt = BIDX * NTHREADS + TIDV, NGT = GDIM * NTHREADS;
    LAS float* scr = (LAS float*)(lds + wave * 16384);
    for (int l = 0; l < 2; ++l) {
        bf16_t* wl = (bf16_t*)(P.ws + WS_W) + (size_t)l * WL_END;
        constexpr int I_IN = 16 * 224, I_BR = 8 * 32, I_OUT = 16 * 32, I_FI = 16 * 176, I_FO = 44 * 32, I_M = 2 * 4;
        constexpr int NIT = I_IN + 3 * I_BR + I_OUT + I_FI + I_FO + 12 * I_M;
        for (int it = gw; it < NIT; it += NGW) {
            int r = it;
            if (r < I_IN) { const int kb = r / 224, nb = r % 224; tr_item(P.in[10] + (size_t)l * D * DIN_SRC, DIN_SRC, D, 64 * kb, win_src(32 * nb), wl + WL_WIN, 32 * nb, scr, lane); continue; } r -= I_IN;
            if (r < 3 * I_BR) { const int b = r / I_BR, q = r % I_BR, kb = q / 32, nb = q % 32; tr_item((b == 0 ? P.in[21] : (b == 1 ? P.in[22] : P.in[23])) + (size_t)l * 512 * D, D, 512, 64 * kb, 32 * nb, wl + WL_WBR + (size_t)b * 524288, 32 * nb, scr, lane); continue; } r -= 3 * I_BR;
            if (r < I_OUT) { const int kb = r / 32, nb = r % 32; tr_item(P.in[24] + (size_t)l * D * D, D, D, 64 * kb, 32 * nb, wl + WL_WOUT, 32 * nb, scr, lane); continue; } r -= I_OUT;
            if (r < I_FI) { const int kb = r / 176, nb = r % 176; tr_item(P.in[26] + (size_t)l * D * 2 * DFF, 2 * DFF, D, 64 * kb, wfi_src(32 * nb), wl + WL_WFI, 32 * nb, scr, lane); continue; } r -= I_FI;
            if (r < I_FO) { const int kb = r / 32, nb = r % 32; tr_item(P.in[27] + (size_t)l * DFF * D, D, DFF, 64 * kb, 32 * nb, wl + WL_WFO, 32 * nb, scr, lane); continue; } r -= I_FO;
            { const int mh = r / I_M, q = r % I_M, kb = q / 4, nb = q % 4, mt = mh / 4, hd = mh % 4;
              tr_item((mt == 0 ? P.in[15] : (mt == 1 ? P.in[16] : P.in[17])) + ((size_t)l * 4 + hd) * 16384, 128, 128, 64 * kb, 32 * nb, wl + WL_WM + (size_t)mh * 16384, 32 * nb, scr, lane); }
        }
        float* wsm = (float*)(wl + WL_WSM);
        for (int i = gt; i < 24 * D; i += NGT) { const int j = i >> 10, k = i & 1023; const int src = j < 8 ? 2560 + j : 4104 + (j - 8); wsm[i] = P.in[10][(size_t)l * D * DIN_SRC + (size_t)k * DIN_SRC + src]; }
    }
    float* rot = (float*)(P.ws + WS_ROT);
    for (int i = gt; i < 2128 * 32; i += NGT) { const int pos = i >> 5, k = i & 31; const double inv = exp(-log(10000.0) * (double)k / 31.0), ang = (double)pos * inv; rot[2 * i] = (float)cos(ang); rot[2 * i + 1] = (float)sin(ang); }
    float* X = (float*)(P.ws + WS_X);
    for (int row = gw; row < MTOT; row += NGW) {
        int g = 0, lr = row; if (row >= G0ROWS) { g = 1 + (row - G0ROWS) / GROWS; lr = (row - G0ROWS) % GROWS; }
        const float* src = nullptr;
        if (g != 0 || lr < 8192) src = P.in[0] + ((size_t)(4 * g + (lr >> 11)) * 2048 + (lr & 2047)) * D;
        else if (lr < 8704) src = P.in[1] + (size_t)(lr - 8192) * D;
        else if (lr < 8720) src = P.in[8] + (size_t)(lr - 8704) * D;
        f32x4* dst = (f32x4*)(X + (size_t)row * D);
#pragma unroll
        for (int j = 0; j < 4; ++j) dst[lane + 64 * j] = src ? ((const f32x4*)src)[lane + 64 * j] : (f32x4){0.f, 0.f, 0.f, 0.f};
    }
}

template <int RB> DI void norm_rows(float* X, const f32x4 (&gv)[4], bf16_t* XN, const float* wsm, float* SM, int row0, int lane, const float* part) {
    f32x4 v[RB][4];
#pragma unroll
    for (int r = 0; r < RB; ++r) {
        const int row = row0 + r; const f32x4* xr = (const f32x4*)(X + (size_t)row * D); float ss = 0.f;
#pragma unroll
        for (int j = 0; j < 4; ++j) v[r][j] = xr[lane + 64 * j];
        if (part && row >= MMAIN) {
#pragma unroll 1
            for (int kh = 0; kh < NKSL; ++kh) { const f32x4* pr = (const f32x4*)(part + ((size_t)kh * (MTOT - MMAIN) + (row - MMAIN)) * 1024);
#pragma unroll
                for (int j = 0; j < 4; ++j) v[r][j] += pr[lane + 64 * j]; }
#pragma unroll
            for (int j = 0; j < 4; ++j) ((f32x4*)(X + (size_t)row * D))[lane + 64 * j] = v[r][j];
        }
#pragma unroll
        for (int j = 0; j < 4; ++j) ss += (v[r][j][0] * v[r][j][0] + v[r][j][1] * v[r][j][1]) + (v[r][j][2] * v[r][j][2] + v[r][j][3] * v[r][j][3]);
        const float rs = rsqrtf(wave_sum(ss) * (1.f / D) + EPS);
        u32x2* o = (u32x2*)(XN + (size_t)row * D);
#pragma unroll
        for (int j = 0; j < 4; ++j) { v[r][j] = v[r][j] * rs * gv[j]; u32x2 w; w.x = cvt_pk_bf16(v[r][j][0], v[r][j][1]); w.y = cvt_pk_bf16(v[r][j][2], v[r][j][3]); o[lane + 64 * j] = w; }
    }
    if (wsm) {
        float mine[RB];
#pragma unroll
        for (int r = 0; r < RB; ++r) mine[r] = 0.f;
#pragma unroll 1
        for (int jj = 0; jj < 24; ++jj) {
            const f32x4* wr = (const f32x4*)(wsm + (size_t)jj * D); f32x4 w[4];
#pragma unroll
            for (int j = 0; j < 4; ++j) w[j] = wr[lane + 64 * j];
#pragma unroll
            for (int r = 0; r < RB; ++r) { float p = 0.f;
#pragma unroll
                for (int j = 0; j < 4; ++j) p += (v[r][j][0] * w[j][0] + v[r][j][1] * w[j][1]) + (v[r][j][2] * w[j][2] + v[r][j][3] * w[j][3]);
                p = wave_sum(p); if (lane == jj) mine[r] = p; }
        }
#pragma unroll
        for (int r = 0; r < RB; ++r) if (lane < 32) SM[(size_t)(row0 + r) * 32 + lane] = mine[r];
    }
}
DI void norm_phase(float* X, const float* gain, bf16_t* XN, const float* wsm, float* SM, int wave, int lane, const float* part = nullptr) {
    const int gw = BIDX * 8 + wave, NGW = GDIM * 8;
    f32x4 gv[4];
#pragma unroll
    for (int j = 0; j < 4; ++j) gv[j] = ((const f32x4*)gain)[lane + 64 * j];
    if (wsm) { for (int row0 = gw * 4; row0 < MTOT; row0 += NGW * 4) norm_rows<4>(X, gv, XN, wsm, SM, row0, lane, part); }
    else { for (int row = gw; row < MTOT; row += NGW) norm_rows<1>(X, gv, XN, nullptr, nullptr, row, lane, part); }
}
#ifndef YSCALE
#define YSCALE 1.2f
#endif
DI void final_phase(PARAMS P, int wave, int lane) {
    const int gw = BIDX * 8 + wave, NGW = GDIM * 8;
    const float* X = (const float*)(P.ws + WS_X);
    f32x4 gv[4];
#pragma unroll
    for (int j = 0; j < 4; ++j) gv[j] = ((const f32x4*)P.in[28])[lane + 64 * j];
    for (int row = gw; row < MTOT; row += NGW) {
        int g = 0, lr = row; if (row >= G0ROWS) { g = 1 + (row - G0ROWS) / GROWS; lr = (row - G0ROWS) % GROWS; }
        float* dst;
        if (g != 0 || lr < 8192) dst = P.out + O_YP + ((size_t)(4 * g + (lr >> 11)) * 2048 + (lr & 2047)) * D;
        else if (lr < 8704) dst = P.out + O_YS + (size_t)(lr - 8192) * D;
        else continue;
        const f32x4* xr = (const f32x4*)(X + (size_t)row * D);
        f32x4 v[4]; float ss = 0.f;
#pragma unroll
        for (int j = 0; j < 4; ++j) v[j] = xr[lane + 64 * j];
        if (row >= MMAIN) { const float* part = (const float*)(P.ws + WS_PART);
#pragma unroll 1
            for (int kh = 0; kh < NKSL; ++kh) { const f32x4* pr = (const f32x4*)(part + ((size_t)kh * (MTOT - MMAIN) + (row - MMAIN)) * 1024);
#pragma unroll
                for (int j = 0; j < 4; ++j) v[j] += pr[lane + 64 * j]; } }
#pragma unroll
        for (int j = 0; j < 4; ++j) ss += (v[j][0] * v[j][0] + v[j][1] * v[j][1]) + (v[j][2] * v[j][2] + v[j][3] * v[j][3]);
        const float rs = rsqrtf(wave_sum(ss) * (1.f / D) + EPS);
#pragma unroll
        for (int j = 0; j < 4; ++j) ((f32x4*)dst)[lane + 64 * j] = v[j] * rs * gv[j];
    }
}

constexpr int PL_A = 0, PL_B = 66560, PL_GA = 133120, PL_MI = 137216, PL_MF = 138240, PL_WST = 139264;
DI void prep_phase(PARAMS P, int l, int g, LAS unsigned char* lds, int wave, int lane) {
    const int tid = TIDV;
    bf16_t* gb = (bf16_t*)(P.ws + WS_G);
    const float* SM = (const float*)(P.ws + WS_SM) + (size_t)gbase(g) * 32;
    const bf16_t* wm = (const bf16_t*)(P.ws + WS_W) + (size_t)l * WL_END + WL_WM;
    float* DECG = (float*)(P.ws + WS_DECG); float* MCH = (float*)(P.ws + WS_MCH); float* DN = (float*)(P.ws + WS_DN); f32x4* TS = (f32x4*)(P.ws + WS_TS);
    LAS float* Bl = (LAS float*)(lds + PL_A); LAS bf16_t* Cl = (LAS bf16_t*)(lds + PL_A); LAS bf16_t* Xl = (LAS bf16_t*)(lds + PL_B);
    LAS float* GAl = (LAS float*)(lds + PL_GA); LAS float* MIl = (LAS float*)(lds + PL_MI); LAS float* MFl = (LAS float*)(lds + PL_MF); LAS float* WSTl = (LAS float*)(lds + PL_WST);
    const int nch = g == 0 ? 137 : 128;
    for (int it = BIDX; it < 2 * nch; it += GDIM) {
        const int cid = it >> 1, part = it & 1;
        const int row0 = cid * 64, L = (g == 0 && cid == 136) ? 16 : 64;
        for (int i = tid; i < 64 * 24; i += NTHREADS) { const int t = i / 24, j = i % 24; const float v = SM[(size_t)(row0 + t) * 32 + j];
            if (j < 4) MIl[t * 4 + j] = v; else if (j < 8) MFl[t * 4 + j - 4] = v; else GAl[t * 16 + j - 8] = v; }
        __syncthreads();
        if (part == 0) {
            const int c = tid & 255, half = tid >> 8, tb = 32 * half; float wa[16];
            LAS float* Tl = (LAS float*)(lds + PL_WST + 1024);
#pragma unroll
            for (int r = 0; r < 16; ++r) wa[r] = P.in[19][((size_t)l * 16 + r) * 256 + c];
            const float ba = P.in[20][l * 256 + c]; float b = 0.f;
#pragma unroll 2
            for (int t = tb; t < tb + 32; ++t) { float s = ba;
#pragma unroll
                for (int r = 0; r < 16; ++r) s += GAl[t * 16 + r] * wa[r];
                const float ls = fminf(s, 0.f) - __logf(1.f + __expf(-fabsf(s)));
                b += (t < L) ? ls * (1.f / 16.f) : 0.f; Bl[t * 256 + c] = b; }
            Tl[half * 256 + c] = b;
            __syncthreads();
            const float boff = half ? Tl[c] : 0.f, bl = Tl[c] + Tl[256 + c];
            if (half == 0) DECG[cid * 256 + c] = __expf(bl);
            bf16_t* gq = gb + (size_t)CP_GQ * G0ROWS; bf16_t* gk = gb + (size_t)CP_GK * G0ROWS; bf16_t* ks = gb + (size_t)CP_KSTG * G0ROWS;
#pragma unroll 1
            for (int t0 = tb; t0 < tb + 32; t0 += 8) {
                float qv[8], kv[8];
#pragma unroll
                for (int j = 0; j < 8; ++j) { const size_t o = (size_t)(row0 + t0 + j) * 256 + c; qv[j] = bf2f(gq[o]); kv[j] = bf2f(gk[o]); }
#pragma unroll
                for (int j = 0; j < 8; ++j) { const int t = t0 + j; const float bt = Bl[t * 256 + c] + boff; const size_t o = (size_t)(row0 + t) * 256 + c;
                    gq[o] = f2bf(qv[j] * __expf(bt)); gk[o] = f2bf(kv[j] * __expf(-bt)); ks[o] = f2bf(t < L ? kv[j] * __expf(bl - bt) : 0.f); }
            }
        } else if (part == 1 && wave == 4) {
            const int t = lane;
#pragma unroll
            for (int h = 0; h < 4; ++h) {
                float ig = MIl[t * 4 + h] + P.in[11][l * 4 + h], lf = logsig(MFl[t * 4 + h] + P.in[12][l * 4 + h]);
                if (t >= L) { ig = -INFINITY; lf = 0.f; }
                float b = lf;
#pragma unroll
                for (int d = 1; d < 64; d <<= 1) { const float v = __shfl_up(b, d); if (lane >= d) b += v; }
                const float a = ig - b; float gm = a;
#pragma unroll
                for (int d = 1; d < 64; d <<= 1) { const float v = __shfl_up(gm, d); if (lane >= d) gm = fmaxf(gm, v); }
                const float bl = __shfl(b, 63), mloc = bl + __shfl(gm, 63);
                WSTl[h * 64 + t] = __expf(a + bl - mloc);
                TS[(size_t)(row0 + t) * 4 + h] = (f32x4){a, gm, b, 0.f};
                if (lane == 0) { MCH[(cid * 4 + h) * 2] = bl; MCH[(cid * 4 + h) * 2 + 1] = mloc; }
            }
        }
        __syncthreads();
        if (part == 1) {
        {
            const int ch = tid; const bf16_t* mx = gb + (size_t)CP_MX * G0ROWS; bf16_t* cc = gb + (size_t)CP_CC * G0ROWS;
            const float w0 = P.in[13][((size_t)l * 4 + 0) * 512 + ch], w1 = P.in[13][((size_t)l * 4 + 1) * 512 + ch], w2 = P.in[13][((size_t)l * 4 + 2) * 512 + ch], w3 = P.in[13][((size_t)l * 4 + 3) * 512 + ch], cb = P.in[14][l * 512 + ch];
            float x3, x2, x1;
            const bool is_sample = (g == 0 && cid >= 128 && cid < 136), is_meta = (g == 0 && cid == 136);
            if (is_meta) { x3 = x2 = x1 = 0.f; }
            else if (is_sample) { const float* cs = P.in[6] + ((size_t)(l * 8 + (cid - 128)) * 3) * 512 + ch; x3 = cs[0]; x2 = cs[512]; x1 = cs[1024]; }
            else { const int hr = (cid & 31) ? row0 - 3 : 8704 + 13; x3 = bf2f(mx[(size_t)hr * 512 + ch]); x2 = bf2f(mx[(size_t)(hr + 1) * 512 + ch]); x1 = bf2f(mx[(size_t)(hr + 2) * 512 + ch]); }
#pragma unroll 1
            for (int t0 = 0; t0 < 64; t0 += 8) {
                bf16_t xr[8];
#pragma unroll
                for (int j = 0; j < 8; ++j) xr[j] = mx[(size_t)(row0 + t0 + j) * 512 + ch];
#pragma unroll
                for (int j = 0; j < 8; ++j) { const int t = t0 + j; const bf16_t xb = xr[j]; const float x = bf2f(xb);
                    const float cv = silu(cb + w0 * x3 + w1 * x2 + w2 * x1 + w3 * x); const bf16_t cbf = f2bf(cv);
                    Cl[t * 520 + ch] = cbf; Xl[t * 520 + ch] = xb; cc[(size_t)(row0 + t) * 512 + ch] = cbf;
                    x3 = x2; x2 = x1; x1 = x; }
            }
            if (is_sample) { float* o = P.out + O_SCONV + ((size_t)(l * 8 + (cid - 128)) * 3) * 512 + ch; o[0] = x3; o[512] = x2; o[1024] = x1; }
            else if (!is_meta && (cid & 31) == 31) { float* o = P.out + O_PCONV + ((size_t)(l * 16 + 4 * g + (cid >> 5)) * 3) * 512 + ch; o[0] = x3; o[512] = x2; o[1024] = x1; }
        }
        __syncthreads();
        {
            const int r = lane & 31, hh = lane >> 5;
#pragma unroll 1
            for (int cbk = wave * 6; cbk < wave * 6 + 6; ++cbk) {
                const int mt = cbk >> 4, hd = (cbk >> 2) & 3, nb = cbk & 3;
                const bf16_t* wt = wm + (size_t)(mt * 4 + hd) * 16384 + (size_t)(32 * nb + r) * 128 + 8 * hh;
                const LAS bf16_t* al = (mt == 2 ? Xl : Cl) + r * 520 + hd * 128 + 8 * hh;
                f32x16 a0, a1;
#pragma unroll
                for (int i = 0; i < 16; ++i) { a0[i] = 0.f; a1[i] = 0.f; }
#pragma unroll
                for (int ks = 0; ks < 8; ++ks) {
                    const bf16x8 b = *(const bf16x8*)(wt + 16 * ks);
                    const bf16x8 x0 = *(const LAS bf16x8*)(al + 16 * ks), x1 = *(const LAS bf16x8*)(al + 32 * 520 + 16 * ks);
                    a0 = MFMA32(x0, b, a0); a1 = MFMA32(x1, b, a1);
                }
                const int e = hd * 128 + 32 * nb + r;
                if (mt == 1) {
                    bf16_t* mk = gb + (size_t)CP_MK * G0ROWS; bf16_t* mks = gb + (size_t)CP_MKST * G0ROWS; float dn = 0.f;
#pragma unroll
                    for (int i = 0; i < 16; ++i) {
                        int t0 = crow(i, hh); asm volatile("" : "+v"(t0)); const int t1 = 32 + t0; const float k0 = a0[i] * 0.08838834764831845f, k1 = a1[i] * 0.08838834764831845f;
                        const float w0 = WSTl[hd * 64 + t0], w1 = WSTl[hd * 64 + t1];
                        mk[(size_t)(row0 + t0) * 512 + e] = f2bf(k0); mk[(size_t)(row0 + t1) * 512 + e] = f2bf(k1);
                        mks[(size_t)(row0 + t0) * 512 + e] = f2bf(k0 * w0); mks[(size_t)(row0 + t1) * 512 + e] = f2bf(k1 * w1);
                        dn += k0 * w0 + k1 * w1;
                    }
                    dn += __shfl_xor(dn, 32);
                    if (hh == 0) DN[(size_t)(cid * 4 + hd) * 128 + 32 * nb + r] = dn;
                } else {
                    bf16_t* o = gb + (size_t)(mt == 0 ? CP_MQ : CP_MV) * G0ROWS;
#pragma unroll
                    for (int i = 0; i < 16; ++i) { int t0 = crow(i, hh); asm volatile("" : "+v"(t0)); o[(size_t)(row0 + t0) * 512 + e] = f2bf(a0[i]); o[(size_t)(row0 + 32 + t0) * 512 + e] = f2bf(a1[i]); }
                }
            }
        }
        }
        __syncthreads();
    }
}

#ifndef PRECH
#define PRECH 136
#endif
template <int BR> DI void scan_item(PARAMS P, int l, int g, int seq, int h, int vs, int ct, int lane, LAS unsigned char* wlds) {
    constexpr int DK = BR == 1 ? 128 : 64, KW = BR == 1 ? 512 : 256;
    const int r = lane & 31, hh = lane >> 5;
    const bf16_t* gb = (const bf16_t*)(P.ws + WS_G);
    const bf16_t* KST = gb + (size_t)(BR == 0 ? CP_KSTR : (BR == 1 ? CP_MKST : CP_KSTG)) * G0ROWS + h * DK + r;
    const bf16_t* V = gb + (size_t)(BR == 0 ? CP_RV : (BR == 1 ? CP_MV : CP_GV)) * G0ROWS + h * 128 + 32 * vs + r;
    bf16_t* SP = (bf16_t*)((unsigned char*)P.out + (BR == 0 ? DS_SPR : (BR == 1 ? DS_SPM : DS_SPG)));
    const float* DECG = (const float*)(P.ws + WS_DECG); const float* MCH = (const float*)(P.ws + WS_MCH); const float* DN = (const float*)(P.ws + WS_DN);
    float* NPv = (float*)(P.ws + WS_NP); float* MPv = (float*)(P.ws + WS_MP);
    int pre = -1, c0, nch = 1; const float* s0 = nullptr; float* fin = nullptr; int sidx = 0; bool sample = false;
    if (seq < 4) { pre = PRECH; c0 = 32 * seq; nch = 32; sidx = l * 16 + 4 * g + seq;
        fin = P.out + (BR == 0 ? O_PRET : (BR == 1 ? O_PC : O_PGLA)) + ((size_t)sidx * 4 + h) * DK * 128; }
    else if (seq < 12) { sample = true; c0 = 128 + (seq - 4); sidx = l * 8 + (seq - 4);
        s0 = P.in[BR == 0 ? 2 : (BR == 1 ? 3 : 7)] + ((size_t)sidx * 4 + h) * DK * 128;
        fin = P.out + (BR == 0 ? O_SRET : (BR == 1 ? O_SC : O_SGLA)) + ((size_t)sidx * 4 + h) * DK * 128; }
    else { c0 = 136; }
    f32x16 S;
#pragma unroll
    for (int i = 0; i < 16; ++i) S[i] = s0 ? s0[(size_t)(32 * ct + crow(i, hh)) * 128 + 32 * vs + r] : 0.f;
    const bool own_n = (BR == 1 && vs == 0 && ct == 0);
    float m = 0.f, n0 = 0.f, n1 = 0.f;
    if (BR == 1 && sample) { m = P.in[5][sidx * 4 + h]; n0 = P.in[4][((size_t)sidx * 4 + h) * 128 + lane]; n1 = P.in[4][((size_t)sidx * 4 + h) * 128 + 64 + lane]; }
    const float lg = lg2gamma(h);
    const bf16_t* KSTb = KST - r; const bf16_t* Vb = V - r;
    LAS bf16_t* Atl = (LAS bf16_t*)wlds; LAS bf16_t* Btl = (LAS bf16_t*)(wlds + 5120);
#define SCAN_LOAD(AF, BF, CID) do { const int r0_ = (CID) * 64; _Pragma("unroll") for (int k = 0; k < 4; ++k) { const int id_ = lane + 64 * k, rw_ = id_ >> 2, q_ = id_ & 3; \
        AF[k] = *(const u32x4*)(KSTb + (size_t)(r0_ + rw_) * KW + 32 * ct + 8 * q_); BF[k] = *(const u32x4*)(Vb + (size_t)(r0_ + rw_) * 512 + 8 * q_); } } while (0)
#define SCAN_LOAD_DEC(DV, BLV, MLV, D0, D1, CID) do { if (BR == 2) { _Pragma("unroll") for (int i = 0; i < 16; ++i) DV[i] = DECG[(CID) * 256 + h * 64 + 32 * ct + crow(i, hh)]; } \
        if (BR == 1) { BLV = MCH[((CID) * 4 + h) * 2]; MLV = MCH[((CID) * 4 + h) * 2 + 1]; if (own_n) { D0 = DN[(size_t)((CID) * 4 + h) * 128 + lane]; D1 = DN[(size_t)((CID) * 4 + h) * 128 + 64 + lane]; } } } while (0)
    u32x4 an[4], bn[4]; float decn[16], bln = 0.f, mln = 0.f, dn0n = 0.f, dn1n = 0.f;
#pragma unroll
    for (int i = 0; i < 16; ++i) decn[i] = 1.f;
    int cidn = pre >= 0 ? pre : c0;
    SCAN_LOAD(an, bn, cidn); SCAN_LOAD_DEC(decn, bln, mln, dn0n, dn1n, cidn);
    for (int ci = (pre >= 0 ? -1 : 0); ci < nch; ++ci) {
        const int cid = cidn;
        u32x4 ta[4], tb[4];
#pragma unroll
        for (int k = 0; k < 4; ++k) { ta[k] = an[k]; tb[k] = bn[k]; }
        float decc[16]; const float blc = bln, mlc = mln, dn0c = dn0n, dn1c = dn1n;
#pragma unroll
        for (int i = 0; i < 16; ++i) decc[i] = decn[i];
        if (ci + 1 < nch) { cidn = c0 + ci + 1; SCAN_LOAD(an, bn, cidn); SCAN_LOAD_DEC(decn, bln, mln, dn0n, dn1n, cidn); }
        asm volatile("s_waitcnt lgkmcnt(0)" ::: "memory");
#pragma unroll
        for (int k = 0; k < 4; ++k) { const int id_ = lane + 64 * k, rw_ = id_ >> 2, q_ = id_ & 3; *(LAS u32x4*)(Atl + rw_ * 40 + 8 * q_) = ta[k]; *(LAS u32x4*)(Btl + rw_ * 40 + 8 * q_) = tb[k]; }
        asm volatile("s_waitcnt lgkmcnt(0)" ::: "memory");
        bf16x8 ac[4], bc[4];
        {
            typedef short s16x4_t __attribute__((ext_vector_type(4)));
            const unsigned lo_ = (unsigned)((8 * hh + ((lane & 15) >> 2)) * 80 + (16 * ((lane >> 4) & 1) + 4 * (lane & 3)) * 2);
            const unsigned aad = (unsigned)(size_t)Atl + lo_, bad = (unsigned)(size_t)Btl + lo_;
            s16x4_t al_[4], ah_[4], bl_[4], bh_[4];
#pragma unroll
            for (int ks = 0; ks < 4; ++ks) {
                asm volatile("ds_read_b64_tr_b16 %0, %1 offset:%c2" : "=&v"(al_[ks]) : "v"(aad), "i"(ks * 1280) : "memory");
                asm volatile("ds_read_b64_tr_b16 %0, %1 offset:%c2" : "=&v"(ah_[ks]) : "v"(aad), "i"(ks * 1280 + 320) : "memory");
                asm volatile("ds_read_b64_tr_b16 %0, %1 offset:%c2" : "=&v"(bl_[ks]) : "v"(bad), "i"(ks * 1280) : "memory");
                asm volatile("ds_read_b64_tr_b16 %0, %1 offset:%c2" : "=&v"(bh_[ks]) : "v"(bad), "i"(ks * 1280 + 320) : "memory");
            }
            asm volatile("s_waitcnt lgkmcnt(0)" ::: "memory");
#pragma unroll
            for (int ks = 0; ks < 4; ++ks) { ac[ks] = __builtin_shufflevector(al_[ks], ah_[ks], 0, 1, 2, 3, 4, 5, 6, 7); bc[ks] = __builtin_shufflevector(bl_[ks], bh_[ks], 0, 1, 2, 3, 4, 5, 6, 7); }
        }
        if (ci >= 0) {
            bf16_t* sp = SP + (size_t)(cid * 4 + h) * 128 * DK + (size_t)((ct * 4) * 2 + hh) * 512 + (size_t)(32 * vs + r) * 4;
#pragma unroll
            for (int q4 = 0; q4 < 4; ++q4) { u32x2 w; w.x = cvt_pk_bf16(S[4 * q4], S[4 * q4 + 1]); w.y = cvt_pk_bf16(S[4 * q4 + 2], S[4 * q4 + 3]); *(u32x2*)(sp + q4 * 1024) = w; }
            if (own_n) { NPv[(size_t)(cid * 4 + h) * 128 + lane] = n0; NPv[(size_t)(cid * 4 + h) * 128 + 64 + lane] = n1; if (lane == 0) MPv[cid * 4 + h] = m; }
        }
        float so = 1.f, sn = 1.f;
        if (BR == 0) so = exp2f((float)((cid == 136) ? 16 : 64) * lg);
        if (BR == 1) { const float bl = blc, ml = mlc; const float mn = fmaxf(bl + m, ml); so = __expf(bl + m - mn); sn = __expf(ml - mn); m = mn;
            n0 = so * n0 + sn * dn0c; n1 = so * n1 + sn * dn1c; }
        {
            f32x16 ds;
#pragma unroll
            for (int i = 0; i < 16; ++i) ds[i] = 0.f;
#pragma unroll
            for (int ks = 0; ks < 4; ++ks) ds = MFMA32(ac[ks], bc[ks], ds);
            if (BR == 2) {
#pragma unroll
                for (int i = 0; i < 16; ++i) S[i] = decc[i] * S[i] + ds[i];
            } else {
#pragma unroll
                for (int i = 0; i < 16; ++i) S[i] = so * S[i] + sn * ds[i];
            }
        }
    }
#undef SCAN_LOAD
#undef SCAN_LOAD_DEC
    if (fin) {
#pragma unroll
        for (int i = 0; i < 16; ++i) fin[(size_t)(32 * ct + crow(i, hh)) * 128 + 32 * vs + r] = S[i];
        if (own_n) {
            float* on = P.out + (sample ? O_SN : O_PN) + ((size_t)sidx * 4 + h) * 128; on[lane] = n0; on[64 + lane] = n1;
            if (lane == 0) P.out[(sample ? O_SMM : O_PM) + sidx * 4 + h] = m;
        }
    }
}
DI void scan_phase(PARAMS P, int l, int g, LAS unsigned char* lds, int wave, int lane) {
    LAS unsigned char* wlds = lds + wave * 10240;
    const int nseq = g == 0 ? 13 : 4, nitems = nseq * 128;
    for (int it = BIDX + GDIM * wave; it < nitems; it += GDIM * 8) {
        const int sh = it >> 5, local = it & 31, seq = sh >> 2, h = sh & 3;
        if (local < 8) scan_item<0>(P, l, g, seq, h, local & 3, local >> 2, lane, wlds);
        else if (local < 24) scan_item<1>(P, l, g, seq, h, (local - 8) & 3, (local - 8) >> 2, lane, wlds);
        else scan_item<2>(P, l, g, seq, h, (local - 24) & 3, (local - 24) >> 2, lane, wlds);
    }
}

constexpr int OL_P = 0, OL_O = 9216, OL_TS = 43008;
template <int BR> DI void out_item(PARAMS P, int l, int cid, int h, LAS unsigned char* lds, int wave, int lane) {
    constexpr int DK = BR == 1 ? 128 : 64, NKS = DK / 16, QW = BR == 1 ? 512 : 256;
    const int tid = TIDV, r = lane & 31, hh = lane >> 5, tt = wave >> 2, vt = wave & 3, row0 = cid * 64;
    const bf16_t* gb = (const bf16_t*)(P.ws + WS_G);
    const bf16_t* Q = gb + (size_t)(BR == 0 ? CP_QINR : (BR == 1 ? CP_MQ : CP_GQ)) * G0ROWS + (size_t)row0 * QW + h * DK;
    const bf16_t* K = gb + (size_t)(BR == 0 ? CP_KINR : (BR == 1 ? CP_MK : CP_GK)) * G0ROWS + (size_t)row0 * QW + h * DK;
    const bf16_t* V = gb + (size_t)(BR == 0 ? CP_RV : (BR == 1 ? CP_MV : CP_GV)) * G0ROWS + (size_t)row0 * 512 + h * 128;
    const bf16_t* GT = gb + (size_t)(BR == 0 ? CP_RG : (BR == 1 ? CP_MZ : CP_GR)) * G0ROWS + (size_t)row0 * 512 + h * 128;
    const bf16_t* ST = (const bf16_t*)((const unsigned char*)P.out + (BR == 0 ? DS_SPR : (BR == 1 ? DS_SPM : DS_SPG))) + (size_t)(cid * 4 + h) * 128 * DK;
    bf16_t* OB = (bf16_t*)((unsigned char*)P.out + DS_OB) + (size_t)BR * G0ROWS * 512 + (size_t)row0 * 512 + h * 128;
    LAS bf16_t* Pl = (LAS bf16_t*)(lds + OL_P); LAS float* Ol = (LAS float*)(lds + OL_O); LAS float* Al = (LAS float*)(lds + OL_TS); LAS float* Gl = Al + 64; LAS float* Bl = Al + 128;
    float mp = 0.f;
    if (BR == 1) {
        mp = ((const float*)(P.ws + WS_MP))[cid * 4 + h];
        if (tid < 64) { const f32x4 ts = ((const f32x4*)(P.ws + WS_TS))[(size_t)(row0 + tid) * 4 + h]; Al[tid] = ts[0]; Gl[tid] = ts[1]; Bl[tid] = ts[2]; }
        __syncthreads();
    }
    bf16x8 vfr[4];
#pragma unroll
    for (int ks = 0; ks < 4; ++ks)
#pragma unroll
        for (int j = 0; j < 8; ++j) vfr[ks][j] = (short)V[(size_t)(16 * ks + 8 * hh + j) * 512 + 32 * vt + r];
    const u32x4 graw0 = *(const u32x4*)(GT + (size_t)(tid >> 3) * 512 + 16 * (tid & 7)), graw1 = *(const u32x4*)(GT + (size_t)(tid >> 3) * 512 + 16 * (tid & 7) + 8);
    f32x16 o;
#pragma unroll
    for (int i = 0; i < 16; ++i) o[i] = 0.f;
#pragma unroll
    for (int ks = 0; ks < NKS; ++ks) {
        const bf16x8 a = *(const bf16x8*)(Q + (size_t)(32 * tt + r) * QW + 16 * ks + 8 * hh);
        typedef short s16x4_o __attribute__((ext_vector_type(4)));
        const bf16_t* stp = ST + (size_t)((((ks >> 1) * 4 + 2 * (ks & 1) + hh) * 2) * 128 + 32 * vt + r) * 4;
        const s16x4_o b0_ = *(const s16x4_o*)stp, b1_ = *(const s16x4_o*)(stp + 512);
        const bf16x8 b = __builtin_shufflevector(b0_, b1_, 0, 1, 2, 3, 4, 5, 6, 7);
        o = MFMA32(a, b, o);
    }
    if (BR == 1) {
#pragma unroll
        for (int i = 0; i < 16; ++i) o[i] *= __expf(mp - fmaxf(mp, Gl[32 * tt + crow(i, hh)]));
    }
    if (wave < 4) {
        const int ts = wave >> 1, ss = wave & 1; f32x16 p;
#pragma unroll
        for (int i = 0; i < 16; ++i) p[i] = 0.f;
        if (ss <= ts) {
#pragma unroll
            for (int ks = 0; ks < NKS; ++ks) {
                const bf16x8 a = *(const bf16x8*)(Q + (size_t)(32 * ts + r) * QW + 16 * ks + 8 * hh), b = *(const bf16x8*)(K + (size_t)(32 * ss + r) * QW + 16 * ks + 8 * hh);
                p = MFMA32(a, b, p);
            }
        }
        const int s = 32 * ss + r; float as = 0.f; if (BR == 1) as = Al[s];
#pragma unroll
        for (int i = 0; i < 16; ++i) { const int t = 32 * ts + crow(i, hh); float v = 0.f;
            if (s <= t) { v = p[i]; if (BR == 1) v *= __expf(as - fmaxf(mp, Gl[t])); }
            Pl[t * 72 + s] = f2bf(v); }
    }
    __syncthreads();
#pragma unroll
    for (int ks = 0; ks < 4; ++ks) {
        const bf16x8 a = *(const LAS bf16x8*)(Pl + (32 * tt + r) * 72 + 16 * ks + 8 * hh);
        o = MFMA32(a, vfr[ks], o);
    }
#pragma unroll
    for (int i = 0; i < 16; ++i) Ol[(32 * tt + crow(i, hh)) * 132 + 32 * vt + r] = o[i];
    __syncthreads();
    {
        const int t = tid >> 3, seg = tid & 7; float ov[16];
#pragma unroll
        for (int e = 0; e < 16; ++e) ov[e] = Ol[t * 132 + 16 * seg + e];
        f32x4 g0, g1, g2, g3; unpack8(graw0, g0, g1); unpack8(graw1, g2, g3);
        const float gate[16] = {g0[0], g0[1], g0[2], g0[3], g1[0], g1[1], g1[2], g1[3], g2[0], g2[1], g2[2], g2[3], g3[0], g3[1], g3[2], g3[3]};
        float outv[16];
        if (BR == 1) {
            float ps = 0.f;
#pragma unroll
            for (int e = 0; e < 8; ++e) ps += bf2f(Pl[t * 72 + 8 * seg + e]);
            const float* np = (const float*)(P.ws + WS_NP) + (size_t)(cid * 4 + h) * 128 + 16 * seg; const bf16_t* qp = Q + (size_t)t * QW + 16 * seg; float qn = 0.f;
#pragma unroll
            for (int e = 0; e < 16; ++e) qn += bf2f(qp[e]) * np[e];
            ps += __shfl_xor(ps, 1); ps += __shfl_xor(ps, 2); ps += __shfl_xor(ps, 4);
            qn += __shfl_xor(qn, 1); qn += __shfl_xor(qn, 2); qn += __shfl_xor(qn, 4);
            const float mg = fmaxf(mp, Gl[t]), den = ps + __expf(mp - mg) * qn, mt = Bl[t] + mg, dd = fmaxf(fabsf(den), __expf(-mt)), inv = 1.f / dd;
#pragma unroll
            for (int e = 0; e < 16; ++e) ov[e] *= inv;
        }
        float sq = 0.f;
#pragma unroll
        for (int e = 0; e < 16; ++e) sq += ov[e] * ov[e];
        sq += __shfl_xor(sq, 1); sq += __shfl_xor(sq, 2); sq += __shfl_xor(sq, 4);
        const float rs = rsqrtf(sq * (1.f / 128.f) + EPS);
        if (BR == 1) {
            const bf16_t* cp = gb + (size_t)CP_CC * G0ROWS + (size_t)(row0 + t) * 512 + h * 128 + 16 * seg; const float* sk = P.in[18] + l * 512 + h * 128 + 16 * seg;
#pragma unroll
            for (int e = 0; e < 16; ++e) outv[e] = gate[e] * (ov[e] * rs + sk[e] * bf2f(cp[e]));
        } else {
#pragma unroll
            for (int e = 0; e < 16; ++e) outv[e] = ov[e] * rs * gate[e];
        }
        u32x4 w0, w1;
        w0.x = cvt_pk_bf16(outv[0], outv[1]); w0.y = cvt_pk_bf16(outv[2], outv[3]); w0.z = cvt_pk_bf16(outv[4], outv[5]); w0.w = cvt_pk_bf16(outv[6], outv[7]);
        w1.x = cvt_pk_bf16(outv[8], outv[9]); w1.y = cvt_pk_bf16(outv[10], outv[11]); w1.z = cvt_pk_bf16(outv[12], outv[13]); w1.w = cvt_pk_bf16(outv[14], outv[15]);
        bf16_t* op = OB + (size_t)t * 512 + 16 * seg; *(u32x4*)op = w0; *(u32x4*)(op + 8) = w1;
    }
    __syncthreads();
}
DI void out_phase(PARAMS P, int l, int g, LAS unsigned char* lds, int wave, int lane) {
    const int nch = g == 0 ? 137 : 128, nitems = nch * 12;
    for (int it = BIDX; it < nitems; it += GDIM) {
        const int h = it & 3, q = it >> 2, br = q % 3, cid = q / 3;
        if (br == 0) out_item<0>(P, l, cid, h, lds, wave, lane); else if (br == 1) out_item<1>(P, l, cid, h, lds, wave, lane); else out_item<2>(P, l, cid, h, lds, wave, lane);
    }
}

#define XB_TMO      128
#define XB_XCNT(j)  (256  + 64 * (j))
#define XB_XSUB(j)  (1280 + 64 * (j))
#define XB_XGEN(j)  (2304 + 64 * (j))
#define XB_TOP      3328
#define XB_TOPGEN   3392
#define XCD_BAR_WORDS 3456
#define XB_SPIN_CAP (1u << 18)

__device__ __forceinline__ unsigned xb_ld(unsigned* p)              { return __hip_atomic_load(p, __ATOMIC_RELAXED, __HIP_MEMORY_SCOPE_AGENT); }
__device__ __forceinline__ unsigned xb_add(unsigned* p, unsigned v) { return __hip_atomic_fetch_add(p, v, __ATOMIC_RELAXED, __HIP_MEMORY_SCOPE_AGENT); }
__device__ __forceinline__ unsigned xb_xcc_id() { return (unsigned)__builtin_amdgcn_s_getreg((3 << 11) | 20) & 0xFu; }
#define XB_SPIN(cond, bar) do { unsigned _sp = 0; while (cond) { __builtin_amdgcn_s_sleep(1); \
    if ((++_sp & 255u) == 0u) { if (xb_ld(&(bar)[XB_TMO])) break; if (_sp > XB_SPIN_CAP) { atomicAdd(&(bar)[XB_TMO], 1u); break; } } } } while (0)

struct XcdBarrier {
    unsigned* bar; unsigned x;
    volatile LAS unsigned* st;
};

__device__ __forceinline__ XcdBarrier xcd_barrier_post(unsigned* bar, volatile LAS unsigned* st) {
    XcdBarrier b; b.bar = bar; b.x = xb_xcc_id(); b.st = st;
    if (threadIdx.x == 0) (void)xb_add(&bar[XB_XCNT(b.x)], 1u);
    return b;
}
__device__ __forceinline__ void xcd_barrier_complete(unsigned* bar, unsigned x, unsigned& nloc, unsigned& nx) {
    const unsigned G = gridDim.x * gridDim.y * gridDim.z;
    unsigned sum, cnt, mine, sp = 0u;
    for (;;) {
        sum = 0u; cnt = 0u; mine = 0u;
#pragma unroll
        for (unsigned j = 0; j < 16; ++j) { const unsigned c = xb_ld(&bar[XB_XCNT(j)]); sum += c; cnt += (c > 0u) ? 1u : 0u; mine = (j == x) ? c : mine; }
        if (sum == G) break;
        __builtin_amdgcn_s_sleep(1);
        if ((++sp & 255u) == 0u) { if (xb_ld(&bar[XB_TMO])) break; if (sp > XB_SPIN_CAP) { atomicAdd(&bar[XB_TMO], 1u); break; } }
    }
    nloc = mine > 0u ? mine : 1u; nx = cnt > 0u ? cnt : 1u;
}

__device__ __forceinline__ void xcd_barrier(const XcdBarrier& b) {
    asm volatile("s_waitcnt vmcnt(0)" ::: "memory");
    __syncthreads();
    if (threadIdx.x == 0) {
        unsigned* bar = b.bar;
        __builtin_amdgcn_s_waitcnt(0);
        unsigned nloc = b.st[0], nx = b.st[1];
        if (nloc == 0u) { xcd_barrier_complete(bar, b.x, nloc, nx); b.st[0] = nloc; b.st[1] = nx; }
        const unsigned old = xb_add(&bar[XB_XSUB(b.x)], 1u);
        const unsigned gen = old / nloc;
        if (old + 1u == (gen + 1u) * nloc) {
            __builtin_amdgcn_fence(__ATOMIC_RELEASE, "agent");
            asm volatile("s_waitcnt vmcnt(0)" ::: "memory");
            const unsigned og = xb_add(&bar[XB_TOP], 1u);
            const unsigned tg = og / nx;
            if (og + 1u == (tg + 1u) * nx) xb_add(&bar[XB_TOPGEN], 1u);
            else XB_SPIN(xb_ld(&bar[XB_TOPGEN]) == tg, bar);
            __builtin_amdgcn_fence(__ATOMIC_ACQUIRE, "agent");
            xb_add(&bar[XB_XGEN(b.x)], 1u);
            asm volatile("s_waitcnt vmcnt(0)" ::: "memory");
        } else {
            XB_SPIN(xb_ld(&bar[XB_XGEN(b.x)]) == gen, bar);
            __builtin_amdgcn_fence(__ATOMIC_ACQUIRE, "agent");
            asm volatile("s_waitcnt vmcnt(0)" ::: "memory");
        }
    }
    __syncthreads();
}

#ifndef PHMASK
#define PHMASK 0xFFFF
#endif
#ifndef MK_SINGLE
#define MK_SINGLE 1
#endif
constexpr int NPHASE = 52;
DI void phase_decode(int ph, int& kind, int& l, int& g) {
    l = 0; g = 0;
    if (ph == 0) kind = 0; else if (ph == NPHASE - 1) kind = 11;
    else { const int q = ph - 1; l = q / 25; const int r = q % 25;
        if (r == 0) kind = 1; else if (r == 1) kind = 2; else if (r >= 22) kind = 8 + (r - 22); else { g = (r - 2) / 5; kind = 3 + (r - 2) % 5; } }
}
template <int KIND> DI void run_phase(PARAMS P, int l, int g) {
    extern __shared__ __attribute__((aligned(16))) unsigned char lds_raw[];
    LAS unsigned char* lds = (LAS unsigned char*)lds_raw;
    const int lane = TIDV & 63, wave = __builtin_amdgcn_readfirstlane(TIDV >> 6);
    const bf16_t* wl = (const bf16_t*)(P.ws + WS_W) + (size_t)l * WL_END;
    float* X = (float*)(P.ws + WS_X); bf16_t* XN = (bf16_t*)(P.ws + WS_XN); bf16_t* gb = (bf16_t*)(P.ws + WS_G);
    const int gr = grows(g), gbs = gbase(g);
    if constexpr (KIND == 0) prologue(P, lds, wave, lane);
    else if constexpr (KIND == 1) norm_phase(X, P.in[9] + l * D, XN, (const float*)(wl + WL_WSM), (float*)(P.ws + WS_SM), wave, lane, l > 0 ? (const float*)(P.ws + WS_PART) : nullptr);
    else if constexpr (KIND == 2) { pg8::Gemm gm{XN + (size_t)gbs * D, wl + WL_WIN, gr, NIN, D}; pg8::StaticOrder S; S.init(gr, NIN, GDIM, BIDX);
        EpiIn E{gb, (const float*)(P.ws + WS_ROT), g}; pg8::gemm_phase<EpiIn, pg8::StaticOrder, true, true>(TIDV, lds, gm, S, E); }
    else if constexpr (KIND == 3) prep_phase(P, l, g, lds, wave, lane);
    else if constexpr (KIND == 4) scan_phase(P, l, g, lds, wave, lane);
    else if constexpr (KIND == 5) out_phase(P, l, g, lds, wave, lane);
    else if constexpr (KIND == 6) {
        pg8::Gemm gm{(const bf16_t*)((unsigned char*)P.out + DS_OB), wl + WL_WBR, gr, D, 512};
        BrOrder S; S.S.init(gr, D, GDIM, BIDX);
        EpiBr E{gb + (size_t)CP_ZG * G0ROWS, (float*)((unsigned char*)P.out + DS_MIXF), (bf16_t*)((unsigned char*)P.out + DS_MIXB)};
        pg8::gemm_phase<EpiBr, BrOrder, true, true>(TIDV, lds, gm, S, E); }
    else if constexpr (KIND == 7) {
        { pg8::Gemm gm{(const bf16_t*)((unsigned char*)P.out + DS_MIXB), wl + WL_WOUT, gr, D, D}; pg8::StaticOrder S; S.init(gr, D, GDIM, GDIM - 1 - BIDX);
          EpiRes E{X + (size_t)gbs * D}; pg8::gemm_phase<EpiRes, pg8::StaticOrder, true, true>(TIDV, lds, gm, S, E); }
        if (g < NGROUP - 1) { const int g2 = g + 1, gr2 = grows(g2), gbs2 = gbase(g2);
          pg8::Gemm gm{XN + (size_t)gbs2 * D, wl + WL_WIN, gr2, NIN, D}; pg8::StaticOrder S; S.init(gr2, NIN, GDIM, BIDX);
          EpiIn E{gb, (const float*)(P.ws + WS_ROT), g2}; pg8::gemm_phase<EpiIn, pg8::StaticOrder, true, true>(TIDV, lds, gm, S, E); }
    }
    else if constexpr (KIND == 8) norm_phase(X, P.in[25] + l * D, XN, nullptr, nullptr, wave, lane);
    else if constexpr (KIND == 9) { pg8::Gemm gm{XN, wl + WL_WFI, MTOT, 2 * DFF, D}; pg8::StaticOrder S; S.init(MTOT, 2 * DFF, GDIM, BIDX);
        EpiSwiglu E{gb}; pg8::gemm_phase<EpiSwiglu, pg8::StaticOrder, true, true>(TIDV, lds, gm, S, E); }
    else if constexpr (KIND == 10) {
        { pg8::Gemm gm{gb, wl + WL_WFO, MMAIN, D, DFF}; pg8::StaticOrder S; S.init(MMAIN, D, GDIM, BIDX); EpiRes E{X}; pg8::gemm_phase<EpiRes, pg8::StaticOrder, true, true>(TIDV, lds, gm, S, E); }
        { pg8::Gemm gm{gb, wl + WL_WFO, MTOT, D, 256, DFF}; TailOrder T{(int)GDIM, (int)BIDX}; EpiPart E{(float*)(P.ws + WS_PART)}; pg8::gemm_phase<EpiPart, TailOrder, false, false>(TIDV, lds, gm, T, E); }
    }
    else final_phase(P, wave, lane);
}
#define KARG const __attribute__((address_space(4))) Params* Pp = (const __attribute__((address_space(4))) Params*)__builtin_amdgcn_kernarg_segment_ptr(); asm volatile("" : "+s"(Pp)); PARAMS P = *Pp;
#if MK_SINGLE
__global__ void __launch_bounds__(NTHREADS, 2) fwd_kernel(Params P_) {
    cg::grid_group grid = cg::this_grid();
    extern __shared__ __attribute__((aligned(16))) unsigned char lds_k[];
    volatile LAS unsigned* bst = (volatile LAS unsigned*)((LAS unsigned char*)lds_k + LDS_BYTES - 64);
    if (threadIdx.x < 2) bst[threadIdx.x] = 0u;
    __syncthreads();
    const XcdBarrier bar = xcd_barrier_post((unsigned*)(P_.ws + WS_BAR), bst);
    const int hi = P_.hi < NPHASE ? P_.hi : NPHASE;
    int ph0 = P_.lo;
    if (ph0 == 0) {
        { KARG if (PHMASK & 1) run_phase<0>(P, 0, 0); }
        ph0 = 1;
        if (ph0 < hi) grid.sync();
    }
    for (int ph = ph0; ph < hi; ++ph) {
        KARG
        int kind, l, g; phase_decode(ph, kind, l, g);
        switch (kind) {
        case 1: if (PHMASK & 2) run_phase<1>(P, l, g); break;
        case 2: if (PHMASK & 4) run_phase<2>(P, l, g); break;
        case 3: if (PHMASK & 8) run_phase<3>(P, l, g); break;
        case 4: if (PHMASK & 16) run_phase<4>(P, l, g); break;
        case 5: if (PHMASK & 32) run_phase<5>(P, l, g); break;
        case 6: if (PHMASK & 64) run_phase<6>(P, l, g); break;
        case 7: if (PHMASK & 128) run_phase<7>(P, l, g); break;
        case 8: if (PHMASK & 256) run_phase<8>(P, l, g); break;
        case 9: if (PHMASK & 512) run_phase<9>(P, l, g); break;
        case 10: if (PHMASK & 1024) run_phase<10>(P, l, g); break;
        default: if (PHMASK & 2048) run_phase<11>(P, l, g); break;
        }
        if (ph + 1 < hi) xcd_barrier(bar);
    }
}
#else
template <int KIND> __global__ void __launch_bounds__(NTHREADS, 2) phase_kernel(Params P_) {
    KARG
    int kind, l, g; phase_decode(P_.lo, kind, l, g);
    run_phase<KIND>(P, l, g);
}
#endif

extern "C" void kernel_launch(void* const* d_in, const int* in_sizes, int n_in, void* d_out, int out_size, void* d_ws, size_t ws_size, hipStream_t stream) {
    static int grid = 0;
    if (grid == 0) {
        if (n_in != 29 || (size_t)out_size != O_END || ws_size < WS_END) { fprintf(stderr, "kernel_launch: unexpected shapes n_in %d out %d ws %zu\n", n_in, out_size, ws_size); grid = -1; return; }
        int dev = 0, cus = 0;
        (void)hipGetDevice(&dev); (void)hipDeviceGetAttribute(&cus, hipDeviceAttributeMultiprocessorCount, dev);
#if MK_SINGLE
        (void)hipFuncSetAttribute((const void*)fwd_kernel, hipFuncAttributeMaxDynamicSharedMemorySize, LDS_BYTES);
#else
#define SETATTR(k) (void)hipFuncSetAttribute((const void*)phase_kernel<k>, hipFuncAttributeMaxDynamicSharedMemorySize, LDS_BYTES);
        SETATTR(0) SETATTR(1) SETATTR(2) SETATTR(3) SETATTR(4) SETATTR(5) SETATTR(6) SETATTR(7) SETATTR(8) SETATTR(9) SETATTR(10) SETATTR(11)
#endif
        (void)hipGetLastError();
        grid = cus > 0 ? cus : 256;
    }
    if (grid < 0) return;
    Params p{};
    for (int i = 0; i < 29; ++i) p.in[i] = (const float*)d_in[i];
    p.out = (float*)d_out; p.ws = (unsigned char*)d_ws;
#if MK_SINGLE
    (void)hipMemsetAsync((unsigned char*)d_ws + WS_BAR, 0, 16384, stream);
    p.lo = 0; p.hi = NPHASE;
    void* args[] = {&p};
    hipError_t e = hipLaunchCooperativeKernel((const void*)fwd_kernel, dim3(grid), dim3(NTHREADS), args, LDS_BYTES, stream);
    if (e != hipSuccess) fprintf(stderr, "cooperative launch failed: %s (grid %d)\n", hipGetErrorString(e), grid);
#else
    for (int ph = 0; ph < NPHASE; ++ph) {
        int kind = 0, l = 0, g = 0;
        if (ph == 0) kind = 0; else if (ph == NPHASE - 1) kind = 11;
        else { const int q = ph - 1; l = q / 25; const int r = q % 25; if (r == 0) kind = 1; else if (r == 1) kind = 2; else if (r >= 22) kind = 8 + (r - 22); else { g = (r - 2) / 5; kind = 3 + (r - 2) % 5; } }
        (void)l; (void)g;
        p.lo = ph; p.hi = ph + 1;
        switch (kind) {
#define LAUNCH(k) case k: hipLaunchKernelGGL(phase_kernel<k>, dim3(grid), dim3(NTHREADS), LDS_BYTES, stream, p); break;
        LAUNCH(0) LAUNCH(1) LAUNCH(2) LAUNCH(3) LAUNCH(4) LAUNCH(5) LAUNCH(6) LAUNCH(7) LAUNCH(8) LAUNCH(9) LAUNCH(10) default: hipLaunchKernelGGL(phase_kernel<11>, dim3(grid), dim3(NTHREADS), LDS_BYTES, stream, p); break;
        }
    }
#endif
}
```

```cpp
#include <hip/hip_runtime.h>
#include <hip/hip_cooperative_groups.h>
#include <cstdio>
#include <cstdint>
namespace cg = cooperative_groups;
namespace pg8 {
#define PG8_LAS __attribute__((address_space(3)))
typedef unsigned short bf16_t;
typedef short bf16x8 __attribute__((ext_vector_type(8)));
typedef float f32x4 __attribute__((ext_vector_type(4)));
typedef unsigned u32x4 __attribute__((ext_vector_type(4)));
constexpr int BM = 256, BK = 64, HALF = 128, HTB = HALF * BK * 2  , STAGE_BYTES = 8 * HTB, NXCD = 8, WGM = 8;

__host__ __device__ __forceinline__ int lds_byte(int r, int c) { const int st = (r >> 4) * 2 + (c >> 5), rr = r & 15, cc = c & 31, ob = rr * 64 + cc * 2; return st * 1024 + (ob ^ (((ob >> 9) & 1) << 5)); }
__host__ __device__ __forceinline__ void stage_rc(int b, int& R, int& C) { const int st = b / 1024, sb = b % 1024, swz = sb ^ (((sb >> 9) & 1) << 5); R = (st >> 1) * 16 + swz / 64; C = (st & 1) * 32 + (swz % 64) / 2; }
__host__ __device__ __forceinline__ int perm32(int rho) { const int n = rho >> 4, i = rho & 15; return 8 * (i >> 2) + 4 * n + (i & 3); }

struct Unit { int pm, pn; unsigned offA = 0u, offB = 0u; int z = 0; };
struct Gemm { const bf16_t* A; const bf16_t* Bt; int M, N, K; int ld = 0; };

struct StaticOrder {
    int nM, nN, nwg, G, c;
    __host__ __device__ void init(int M, int N, int G_, int c_) { nM = M / BM; nN = N / BM; nwg = nM * nN; G = G_; c = c_; }
    __host__ __device__ bool next(int i, Unit& u) const {
        const long L = (long)i * G + c; if (L >= nwg) return false;
        int wgid = (int)L; { const int q = nwg / NXCD, r = nwg % NXCD, xcd = wgid % NXCD, off = wgid / NXCD; wgid = (xcd < r ? xcd * (q + 1) : r * (q + 1) + (xcd - r) * q) + off; }
        const int nig = WGM * nN, gid = wgid / nig, fm = gid * WGM, gsz = (nM - fm) < WGM ? (nM - fm) : WGM;
        u.pm = fm + ((wgid % nig) % gsz); u.pn = (wgid % nig) / gsz; return true;
    }
    __device__ __forceinline__ void a_ready(const Unit&) const {}
    __device__ __forceinline__ void done(const Unit&) const {}
};

typedef float f32x2_cv __attribute__((ext_vector_type(2))); typedef __bf16 bf16x2_cv __attribute__((ext_vector_type(2)));
__device__ __forceinline__ unsigned cvt_pk_bf16(float lo, float hi) { const f32x2_cv v = {lo, hi}; const bf16x2_cv b = __builtin_convertvector(v, bf16x2_cv); return __builtin_bit_cast(unsigned, b); }
typedef float f32x2 __attribute__((ext_vector_type(2)));
template <class Epi, class Sched, bool ALIGN_EPI = false, bool SP2 = false>
__device__ __forceinline__ void gemm_phase(const int tid, PG8_LAS unsigned char* lds, const Gemm g, const Sched& S, const Epi& E) {
    const int wid = __builtin_amdgcn_readfirstlane(tid >> 6), lane = tid & 63, wr = wid >> 2, wc = wid & 3, fr = lane & 15, fq = lane >> 4;
    const int K = g.ld ? g.ld : g.K, nt = g.K / BK;
    unsigned voffA[2], voffB[2];
#pragma unroll
    for (int i = 0; i < 2; ++i) { int R, C; stage_rc(tid * 16 + i * 8192, R, C); const int Rb = Epi::PERM ? ((R & ~31) + perm32(R & 31)) : R;
        voffA[i] = (unsigned)(R * K + C) * 2u; voffB[i] = (unsigned)(Rb * K + C) * 2u; }
    const size_t kstep = (size_t)(BK * 2);
    const size_t hstep = (size_t)HALF * K * 2;
    const size_t tstep = 2 * hstep;
    const unsigned ldsw = (unsigned)wid * 1024u;
    const int aoff = lds_byte(wr * 64 + fr, fq * 8), boff = lds_byte(wc * 32 + fr, fq * 8);
#define PG8_SA(b, h) (((b) * 2 + (h)) * HTB)
#define PG8_SB(b, h) ((4 + (b) * 2 + (h)) * HTB)
#define PG8_STAGE(bufoff, gbase, voff) do { _Pragma("unroll") for (int _i = 0; _i < 2; ++_i) \
        __builtin_amdgcn_global_load_lds((const unsigned*)((const char*)(gbase) + (voff)[_i]), (PG8_LAS unsigned*)(lds + (bufoff) + ldsw + _i * 8192), 16, 0, 0); } while (0)
#define PG8_LDA(dst, b, h) do { _Pragma("unroll") for (int m = 0; m < 4; ++m) _Pragma("unroll") for (int k = 0; k < 2; ++k) dst[m][k] = *(const PG8_LAS bf16x8*)(lds + PG8_SA(b, h) + aoff + m * 2048 + k * 1024); } while (0)
#define PG8_LDB(dst, b, h) do { _Pragma("unroll") for (int n = 0; n < 2; ++n) _Pragma("unroll") for (int k = 0; k < 2; ++k) dst[n][k] = *(const PG8_LAS bf16x8*)(lds + PG8_SB(b, h) + boff + n * 2048 + k * 1024); } while (0)
#define PG8_MMA(ai, bj, At, Bt) do { __builtin_amdgcn_s_setprio(1); _Pragma("unroll") for (int m = 0; m < 4; ++m) _Pragma("unroll") for (int n = 0; n < 2; ++n) _Pragma("unroll") for (int k = 0; k < 2; ++k) \
        acc[ai][bj][m][n] = __builtin_amdgcn_mfma_f32_16x16x32_bf16(Bt[n][k], At[m][k], acc[ai][bj][m][n], 0, 0, 0); __builtin_amdgcn_s_setprio(0); } while (0)
#define PG8_WAIT_V(n) asm volatile("s_waitcnt vmcnt(" #n ")" ::: "memory")
#define PG8_WAIT_L(n) asm volatile("s_waitcnt lgkmcnt(" #n ")" ::: "memory")
#define PG8_BAR __builtin_amdgcn_s_barrier()
#define PG8_SCHED __builtin_amdgcn_sched_barrier(0)
    Unit cur, nxt; int ui = 0;
    if (!S.next(0, cur)) return;
    f32x4 acc[2][2][4][2];
#pragma unroll
    for (int a = 0; a < 2; ++a)
#pragma unroll
        for (int b = 0; b < 2; ++b)
#pragma unroll
            for (int m = 0; m < 4; ++m)
#pragma unroll
                for (int n = 0; n < 2; ++n) acc[a][b][m][n] = (f32x4){0.f, 0.f, 0.f, 0.f};
    bf16x8 At[4][2], B0[2][2], B1[2][2];
    const char* cA = (const char*)g.A + (size_t)cur.pm * tstep + cur.offA; const char* cB = (const char*)g.Bt + (size_t)cur.pn * tstep + cur.offB;
    S.a_ready(cur);
    if constexpr (SP2) {
        PG8_STAGE(PG8_SB(0, 0), cB, voffB); PG8_STAGE(PG8_SB(0, 1), cB + hstep, voffB); PG8_STAGE(PG8_SA(0, 0), cA, voffA); PG8_STAGE(PG8_SA(0, 1), cA + hstep, voffA);
        if (wr == 1) PG8_BAR;
        PG8_WAIT_V(2); PG8_BAR;
        PG8_STAGE(PG8_SB(1, 0), cB + kstep, voffB); PG8_STAGE(PG8_SA(1, 0), cA + kstep, voffA); PG8_STAGE(PG8_SB(1, 1), cB + hstep + kstep, voffB);
        PG8_WAIT_V(6); PG8_BAR;
    } else {
        PG8_STAGE(PG8_SB(0, 0), cB, voffB); PG8_STAGE(PG8_SA(0, 0), cA, voffA); PG8_STAGE(PG8_SB(0, 1), cB + hstep, voffB); PG8_STAGE(PG8_SA(0, 1), cA + hstep, voffA);
        if (wr == 1) PG8_BAR;
        PG8_WAIT_V(4); PG8_BAR;
        PG8_STAGE(PG8_SB(1, 0), cB + kstep, voffB); PG8_STAGE(PG8_SA(1, 0), cA + kstep, voffA); PG8_STAGE(PG8_SB(1, 1), cB + hstep + kstep, voffB);
        PG8_WAIT_V(6); PG8_BAR;
    }
    for (;;) {
        const bool has_next = S.next(ui + 1, nxt);
        const char* nA = has_next ? (const char*)g.A + (size_t)nxt.pm * tstep + nxt.offA : cA; const char* nB = has_next ? (const char*)g.Bt + (size_t)nxt.pn * tstep + nxt.offB : cB;
        for (int t = 0; t < nt; t += 2) {
            const bool last = (t == nt - 2);
            const char* a1 = cA + (size_t)(t + 1) * kstep;
            const char* a2 = last ? nA : cA + (size_t)(t + 2) * kstep; const char* b2 = last ? nB : cB + (size_t)(t + 2) * kstep;
            const char* a3 = a2 + kstep; const char* b3 = b2 + kstep;
            if (last && has_next) S.a_ready(nxt);
            if constexpr (SP2) {
            PG8_LDB(B0, 0, 0); PG8_LDB(B1, 0, 1); PG8_SCHED; PG8_LDA(At, 0, 0); PG8_STAGE(PG8_SA(1, 1), a1 + hstep, voffA);
            PG8_WAIT_V(8); PG8_WAIT_L(0); PG8_BAR; PG8_MMA(0, 0, At, B0); PG8_MMA(0, 1, At, B1); PG8_BAR; PG8_SCHED;
            PG8_LDA(At, 0, 1); PG8_STAGE(PG8_SB(0, 0), b2, voffB); PG8_STAGE(PG8_SB(0, 1), b2 + hstep, voffB); PG8_STAGE(PG8_SA(0, 0), a2, voffA);
            PG8_WAIT_V(8); PG8_WAIT_L(0); PG8_BAR; PG8_MMA(1, 0, At, B0); PG8_MMA(1, 1, At, B1); PG8_BAR; PG8_SCHED;
            PG8_LDB(B0, 1, 0); PG8_LDB(B1, 1, 1); PG8_SCHED; PG8_LDA(At, 1, 0); PG8_STAGE(PG8_SA(0, 1), a2 + hstep, voffA);
            PG8_WAIT_V(8); PG8_WAIT_L(0); PG8_BAR; PG8_MMA(0, 0, At, B0); PG8_MMA(0, 1, At, B1); PG8_BAR; PG8_SCHED;
            PG8_LDA(At, 1, 1); PG8_STAGE(PG8_SB(1, 0), b3, voffB); PG8_STAGE(PG8_SB(1, 1), b3 + hstep, voffB); PG8_STAGE(PG8_SA(1, 0), a3, voffA);
            PG8_WAIT_V(8); PG8_WAIT_L(0); PG8_BAR; PG8_MMA(1, 0, At, B0); PG8_MMA(1, 1, At, B1); PG8_BAR; PG8_SCHED;
            } else {
            PG8_LDB(B0, 0, 0); PG8_SCHED; PG8_LDA(At, 0, 0); PG8_STAGE(PG8_SA(1, 1), a1 + hstep, voffA);
            PG8_WAIT_L(8); PG8_BAR; PG8_WAIT_L(0); PG8_MMA(0, 0, At, B0); PG8_BAR; PG8_SCHED;
            PG8_LDB(B1, 0, 1); PG8_STAGE(PG8_SB(0, 0), b2, voffB);
            PG8_BAR; PG8_WAIT_L(0); PG8_MMA(0, 1, At, B1); PG8_BAR;
            PG8_LDA(At, 0, 1); PG8_STAGE(PG8_SA(0, 0), a2, voffA);
            PG8_BAR; PG8_WAIT_L(0); PG8_MMA(1, 0, At, B0); PG8_BAR; PG8_SCHED;
            PG8_STAGE(PG8_SB(0, 1), b2 + hstep, voffB);
            PG8_WAIT_V(6); PG8_BAR; PG8_MMA(1, 1, At, B1); PG8_BAR;
            PG8_LDB(B0, 1, 0); PG8_SCHED; PG8_LDA(At, 1, 0); PG8_STAGE(PG8_SA(0, 1), a2 + hstep, voffA);
            PG8_WAIT_L(8); PG8_BAR; PG8_WAIT_L(0); PG8_MMA(0, 0, At, B0); PG8_BAR; PG8_SCHED;
            PG8_LDB(B1, 1, 1); PG8_STAGE(PG8_SB(1, 0), b3, voffB);
            PG8_BAR; PG8_WAIT_L(0); PG8_MMA(0, 1, At, B1); PG8_BAR;
            PG8_LDA(At, 1, 1); PG8_STAGE(PG8_SA(1, 0), a3, voffA);
            PG8_BAR; PG8_WAIT_L(0); PG8_MMA(1, 0, At, B0); PG8_BAR; PG8_SCHED;
            PG8_STAGE(PG8_SB(1, 1), b3 + hstep, voffB);
            PG8_WAIT_V(6); PG8_BAR; PG8_MMA(1, 1, At, B1); PG8_BAR;
            }
        }
        if constexpr (ALIGN_EPI) { if (wr == 0) PG8_BAR; }
        if constexpr (!Epi::AFTER_DRAIN) { E(acc, cur, wr, wc, fr, fq); S.done(cur); }
        if (!has_next) break;
#pragma unroll
        for (int a = 0; a < 2; ++a)
#pragma unroll
            for (int b = 0; b < 2; ++b)
#pragma unroll
                for (int m = 0; m < 4; ++m)
#pragma unroll
                    for (int n = 0; n < 2; ++n) acc[a][b][m][n] = (f32x4){0.f, 0.f, 0.f, 0.f};
        cur = nxt; cA = nA; cB = nB; ++ui;
        if constexpr (ALIGN_EPI) { if (wr == 1) PG8_BAR; }
    }
    PG8_WAIT_V(0);
    if constexpr (!ALIGN_EPI) { if (wr == 0) PG8_BAR; }
    PG8_BAR;
    if constexpr (Epi::AFTER_DRAIN) { E.fused(acc, cur, wr, wc, fr, fq, lds, wid, lane); S.done(cur); }
#undef PG8_SA
#undef PG8_SB
#undef PG8_STAGE
#undef PG8_LDA
#undef PG8_LDB
#undef PG8_MMA
#undef PG8_WAIT_V
#undef PG8_WAIT_L
#undef PG8_BAR
#undef PG8_SCHED
}
}

#define DI __device__ __forceinline__
#define LAS __attribute__((address_space(3)))
typedef unsigned short bf16_t;
typedef short bf16x8 __attribute__((ext_vector_type(8)));
typedef float f32x4 __attribute__((ext_vector_type(4)));
typedef float f32x16 __attribute__((ext_vector_type(16)));
typedef unsigned u32x4 __attribute__((ext_vector_type(4)));
typedef unsigned u32x2 __attribute__((ext_vector_type(2)));
using pg8::cvt_pk_bf16;

constexpr int D = 1024, NIN = 7168, DFF = 2816, DIN_SRC = 7192;
constexpr int MTOT = 33536, G0ROWS = 8960, GROWS = 8192, NGROUP = 4;
constexpr int NTHREADS = 512;
constexpr float EPS = 1e-6f;
constexpr int LDS_BYTES = 147456;

constexpr size_t WS_X = 0;
constexpr size_t WS_XN = WS_X + (size_t)MTOT * D * 4;
constexpr size_t WS_W = WS_XN + (size_t)MTOT * D * 2;
constexpr size_t WL_WIN = 0, WL_WBR = 7340032, WL_WOUT = 8912896, WL_WFI = 9961472, WL_WFO = 15728640, WL_WM = 18612224, WL_WSM = 18808832, WL_END = 18874368;
constexpr size_t WS_SM = WS_W + 2 * WL_END * 2;
constexpr size_t WS_ROT = WS_SM + (size_t)MTOT * 32 * 4;
constexpr size_t WS_TS = WS_ROT + 2128 * 32 * 8;
constexpr size_t WS_DECG = WS_TS + (size_t)G0ROWS * 64;
constexpr size_t WS_MCH = WS_DECG + 137 * 256 * 4;
constexpr size_t WS_DN = WS_MCH + 137 * 8 * 4 + 32;
constexpr size_t WS_NP = WS_DN + 137 * 512 * 4;
constexpr size_t WS_MP = WS_NP + 137 * 512 * 4;
constexpr size_t WS_BAR = ((WS_MP + 137 * 16 + 4095) / 4096) * 4096;
constexpr size_t WS_G = WS_BAR + 16384;
constexpr size_t WS_PART = WS_G + (size_t)MTOT * DFF * 2;
constexpr int MMAIN = 32768, NKSL = 11;
constexpr size_t WS_END = WS_PART + (size_t)NKSL * (MTOT - MMAIN) * 1024 * 4;
static_assert(WS_END <= 536870912ull, "ws map");
static_assert((size_t)10240 * G0ROWS * 2 <= (size_t)MTOT * DFF * 2, "group region inside HB overlay");
constexpr int CP_QINR = 0, CP_KINR = 256, CP_KSTR = 512, CP_RV = 768, CP_RG = 1280, CP_MX = 1792, CP_MZ = 2304, CP_GQ = 2816, CP_GK = 3072, CP_GV = 3328, CP_GR = 3840,
              CP_ZG = 4352, CP_KSTG = 7424, CP_CC = 7680, CP_MQ = 8192, CP_MK = 8704, CP_MKST = 9216, CP_MV = 9728;
constexpr size_t O_YP = 0, O_YS = O_YP + 33554432, O_PRET = O_YS + 524288, O_PC = O_PRET + 1048576, O_PN = O_PC + 2097152, O_PM = O_PN + 16384, O_PCONV = O_PM + 128,
                 O_PGLA = O_PCONV + 49152, O_SRET = O_PGLA + 1048576, O_SC = O_SRET + 524288, O_SN = O_SC + 1048576, O_SMM = O_SN + 8192, O_SCONV = O_SMM + 64, O_SGLA = O_SCONV + 24576,
                 O_END = O_SGLA + 524288;
constexpr size_t DS_SPR = 0;
constexpr size_t DS_SPG = DS_SPR + (size_t)137 * 4 * 128 * 64 * 2;
constexpr size_t DS_SPM = DS_SPG + (size_t)137 * 4 * 128 * 64 * 2;
constexpr size_t DS_OB = DS_SPM + (size_t)137 * 4 * 128 * 128 * 2;
constexpr size_t DS_MIXF = DS_OB + (size_t)3 * G0ROWS * 512 * 2;
constexpr size_t DS_MIXB = DS_MIXF + (size_t)G0ROWS * 1024 * 4;
static_assert(DS_MIXB + (size_t)G0ROWS * 1024 * 2 <= (size_t)33554432 * 4, "d_out scratch");

struct Params { const float* in[29]; float* out; unsigned char* ws; int lo, hi; };
#define PARAMS const __attribute__((address_space(4))) Params&
__device__ __forceinline__ int tid_opaque() { int t = threadIdx.x; asm volatile("" : "+v"(t)); return t; }
#define TIDV tid_opaque()
__device__ __forceinline__ int bid_opaque() { int t = blockIdx.x; asm volatile("" : "+s"(t)); return t; }
__device__ __forceinline__ int gdim_opaque() { int t = gridDim.x; asm volatile("" : "+s"(t)); return t; }
#define BIDX bid_opaque()
#define GDIM gdim_opaque()

DI float bf2f(bf16_t v) { return __uint_as_float((unsigned)v << 16); }
DI bf16_t f2bf(float f) { return (bf16_t)cvt_pk_bf16(f, 0.f); }
DI float sigm(float x) { return __builtin_amdgcn_rcpf(1.f + __expf(-x)); }
DI float silu(float x) { return x * sigm(x); }
DI float logsig(float x) { return fminf(x, 0.f) - log1pf(__expf(-fabsf(x))); }
DI float wave_sum(float v) {
    v += __builtin_bit_cast(float, __builtin_amdgcn_update_dpp(0, __builtin_bit_cast(int, v), 0xB1, 0xF, 0xF, true));
    v += __builtin_bit_cast(float, __builtin_amdgcn_update_dpp(0, __builtin_bit_cast(int, v), 0x4E, 0xF, 0xF, true));
    v += __builtin_bit_cast(float, __builtin_amdgcn_update_dpp(0, __builtin_bit_cast(int, v), 0x141, 0xF, 0xF, true));
    v += __builtin_bit_cast(float, __builtin_amdgcn_update_dpp(0, __builtin_bit_cast(int, v), 0x140, 0xF, 0xF, true));
    const int b = __builtin_bit_cast(int, v);
    return (__builtin_bit_cast(float, __builtin_amdgcn_readlane(b, 0)) + __builtin_bit_cast(float, __builtin_amdgcn_readlane(b, 16))) +
           (__builtin_bit_cast(float, __builtin_amdgcn_readlane(b, 32)) + __builtin_bit_cast(float, __builtin_amdgcn_readlane(b, 48)));
}
DI int gbase(int g) { return g == 0 ? 0 : G0ROWS + (g - 1) * GROWS; }
DI int grows(int g) { return g == 0 ? G0ROWS : GROWS; }
DI int crow(int i, int hh) { return (i & 3) + 8 * (i >> 2) + 4 * hh; }
#define MFMA32(a, b, c) __builtin_amdgcn_mfma_f32_32x32x16_bf16((a), (b), (c), 0, 0, 0)
DI void row_info(int g, int lr, int& pos, int& jc, int& L) {
    if (g != 0 || lr < 8192) { const int t = lr & 2047; pos = 16 + t; jc = t & 63; L = 64; }
    else if (lr < 8704) { const int t = (lr - 8192) & 63; pos = 2064 + t; jc = t; L = 64; }
    else { const int t = lr - 8704; pos = t < 16 ? t : 0; jc = t & 63; L = 16; }
}
DI float lg2gamma(int h) { return log2f(1.0f - exp2f(-5.0f - (float)h)); }

using pg8::Unit;
template <int ACT> DI f32x4 act4(f32x4 v) {
    f32x4 o;
#pragma unroll
    for (int j = 0; j < 4; ++j) { const float x = v[j]; o[j] = ACT == 1 ? silu(x) : (ACT == 2 ? sigm(x) : (ACT == 3 ? x * 0.125f : x)); }
    return o;
}
DI u32x4 pack8(f32x4 a, f32x4 b) { u32x4 w; w.x = cvt_pk_bf16(a[0], a[1]); w.y = cvt_pk_bf16(a[2], a[3]); w.z = cvt_pk_bf16(b[0], b[1]); w.w = cvt_pk_bf16(b[2], b[3]); return w; }
DI void unpack8(u32x4 w, f32x4& a, f32x4& b) {
    a[0] = __uint_as_float(w.x << 16); a[1] = __uint_as_float(w.x & 0xffff0000u); a[2] = __uint_as_float(w.y << 16); a[3] = __uint_as_float(w.y & 0xffff0000u);
    b[0] = __uint_as_float(w.z << 16); b[1] = __uint_as_float(w.z & 0xffff0000u); b[2] = __uint_as_float(w.w << 16); b[3] = __uint_as_float(w.w & 0xffff0000u);
}

#ifndef EPI_ROT
#define EPI_ROT 1
#endif
struct EpiIn {
    static constexpr bool PERM = true, AFTER_DRAIN = false;
    bf16_t* gb; const float* rot; int g;
    DI void operator()(const f32x4 (&acc)[2][2][4][2], const Unit& u, int wr, int wc, int fr, int fq) const {
        const int pn = u.pn, rowb = u.pm * 256 + wr * 64 + fr;
        if (pn <= 1 && EPI_ROT) {
            const float lg = lg2gamma(wc);
#pragma unroll
            for (int ai = 0; ai < 2; ++ai)
#pragma unroll
                for (int m = 0; m < 4; ++m) {
                    int row = rowb + ai * 128 + m * 16; asm volatile("" : "+v"(row));
                    int pos, jc, L; row_info(g, row, pos, jc, L);
                    const f32x4* rp = (const f32x4*)(rot + ((size_t)pos * 32 + 8 * fq) * 2);
                    const float e1 = exp2f((float)(jc + 1) * lg);
                    const float sa = pn == 0 ? e1 : 0.125f / e1, sb = (g == 0 && row >= 8720) ? 0.f : 0.125f * exp2f((float)(L - 1 - jc) * lg);
                    bf16_t* d0 = gb + (size_t)(pn == 0 ? CP_QINR : CP_KINR) * G0ROWS + (size_t)row * 256 + wc * 64 + 8 * fq;
                    bf16_t* d1 = gb + (size_t)CP_KSTR * G0ROWS + (size_t)row * 256 + wc * 64 + 8 * fq;
#pragma unroll
                    for (int n = 0; n < 2; ++n) {
                        const f32x4 cs0 = rp[2 * n], cs1 = rp[2 * n + 1];
                        const f32x4 x1 = acc[ai][0][m][n], x2 = acc[ai][1][m][n];
                        f32x4 o1, o2;
                        o1[0] = x1[0] * cs0[0] - x2[0] * cs0[1]; o2[0] = x1[0] * cs0[1] + x2[0] * cs0[0];
                        o1[1] = x1[1] * cs0[2] - x2[1] * cs0[3]; o2[1] = x1[1] * cs0[3] + x2[1] * cs0[2];
                        o1[2] = x1[2] * cs1[0] - x2[2] * cs1[1]; o2[2] = x1[2] * cs1[1] + x2[2] * cs1[0];
                        o1[3] = x1[3] * cs1[2] - x2[3] * cs1[3]; o2[3] = x1[3] * cs1[3] + x2[3] * cs1[2];
                        u32x2 w; w.x = cvt_pk_bf16(o1[0] * sa, o1[1] * sa); w.y = cvt_pk_bf16(o1[2] * sa, o1[3] * sa); *(u32x2*)(d0 + 4 * n) = w;
                        w.x = cvt_pk_bf16(o2[0] * sa, o2[1] * sa); w.y = cvt_pk_bf16(o2[2] * sa, o2[3] * sa); *(u32x2*)(d0 + 32 + 4 * n) = w;
                        if (pn == 1) {
                            w.x = cvt_pk_bf16(o1[0] * sb, o1[1] * sb); w.y = cvt_pk_bf16(o1[2] * sb, o1[3] * sb); *(u32x2*)(d1 + 4 * n) = w;
                            w.x = cvt_pk_bf16(o2[0] * sb, o2[1] * sb); w.y = cvt_pk_bf16(o2[2] * sb, o2[3] * sb); *(u32x2*)(d1 + 32 + 4 * n) = w;
                        }
                    }
                    asm volatile("" ::: "memory");
                }
            return;
        }
        int W, cp, c0, act;
        if (pn < 4) { cp = CP_RV; W = 512; c0 = (pn - 2) * 256; act = 0; }
        else if (pn < 6) { cp = CP_RG; W = 512; c0 = (pn - 4) * 256; act = 1; }
        else if (pn < 8) { cp = CP_MX; W = 512; c0 = (pn - 6) * 256; act = 0; }
        else if (pn < 10) { cp = CP_MZ; W = 512; c0 = (pn - 8) * 256; act = 2; }
        else if (pn == 10) { cp = CP_GQ; W = 256; c0 = 0; act = 3; }
        else if (pn == 11) { cp = CP_GK; W = 256; c0 = 0; act = 0; }
        else if (pn < 14) { cp = CP_GV; W = 512; c0 = (pn - 12) * 256; act = 0; }
        else if (pn < 16) { cp = CP_GR; W = 512; c0 = (pn - 14) * 256; act = 1; }
        else { cp = CP_ZG; W = 3072; c0 = (pn - 16) * 256; act = 2; }
        bf16_t* base = gb + (size_t)cp * G0ROWS + c0 + wc * 32 + 8 * fq;
        const int row0 = rowb;
        if (act == 0) store_tile<0>(acc, base, row0, W); else if (act == 1) store_tile<1>(acc, base, row0, W); else if (act == 2) store_tile<2>(acc, base, row0, W); else store_tile<3>(acc, base, row0, W);
    }
    template <int ACT> DI static void store_tile(const f32x4 (&acc)[2][2][4][2], bf16_t* base, int rowb, int W) {
#pragma unroll
        for (int ai = 0; ai < 2; ++ai)
#pragma unroll
            for (int m = 0; m < 4; ++m) {
                bf16_t* rp = base + (size_t)(rowb + ai * 128 + m * 16) * W;
#pragma unroll
                for (int bj = 0; bj < 2; ++bj) *(u32x4*)(rp + bj * 128) = pack8(act4<ACT>(acc[ai][bj][m][0]), act4<ACT>(acc[ai][bj][m][1]));
                asm volatile("" ::: "memory");
            }
    }
};

struct BrOrder {
    pg8::StaticOrder S;
    DI bool next(int i, Unit& u) const { if (!S.next(i / 3, u)) return false; const int z = i % 3; u.z = z; u.offA = (unsigned)z * (unsigned)(G0ROWS * 512 * 2); u.offB = (unsigned)z * (unsigned)(524288 * 2); return true; }
    DI void a_ready(const Unit&) const {}
    DI void done(const Unit&) const {}
};
struct EpiBr {
    static constexpr bool PERM = true, AFTER_DRAIN = false;
    const bf16_t* zg0; float* mixf; bf16_t* mixb;
    DI void operator()(const f32x4 (&acc)[2][2][4][2], const Unit& u, int wr, int wc, int fr, int fq) const {
        const int mode = u.z; const bf16_t* zg = zg0 + mode * 1024;
        const int rowb = u.pm * 256 + wr * 64 + fr, colb = u.pn * 256 + wc * 32 + 8 * fq;
#pragma unroll
        for (int ai = 0; ai < 2; ++ai) {
            u32x4 zr[4][2], mr[4][2];
#pragma unroll
            for (int m = 0; m < 4; ++m)
#pragma unroll
                for (int bj = 0; bj < 2; ++bj) { const int row = rowb + ai * 128 + m * 16, col = colb + bj * 128;
                    zr[m][bj] = *(const u32x4*)(zg + (size_t)row * 3072 + col);
                    if (mode != 0) mr[m][bj] = *(const u32x4*)(mixb + (size_t)row * 1024 + col); else mr[m][bj] = (u32x4){0u, 0u, 0u, 0u}; }
#pragma unroll
            for (int m = 0; m < 4; ++m)
#pragma unroll
                for (int bj = 0; bj < 2; ++bj) { const int row = rowb + ai * 128 + m * 16, col = colb + bj * 128;
                    f32x4 z0, z1, p0, p1; unpack8(zr[m][bj], z0, z1); unpack8(mr[m][bj], p0, p1);
                    const f32x4 v0 = acc[ai][bj][m][0] * z0 + p0, v1 = acc[ai][bj][m][1] * z1 + p1;
                    *(u32x4*)(mixb + (size_t)row * 1024 + col) = pack8(v0, v1); }
        }
    }
};

struct EpiRes {
    static constexpr bool PERM = true, AFTER_DRAIN = false;
    float* x;
    DI void operator()(const f32x4 (&acc)[2][2][4][2], const Unit& u, int wr, int wc, int fr, int fq) const {
        const int rowb = u.pm * 256 + wr * 64 + fr, colb = u.pn * 256 + wc * 32 + 8 * fq;
#pragma unroll
        for (int aq = 0; aq < 4; ++aq) {
            const int ai = aq >> 1, m0 = (aq & 1) * 2;
            f32x4 pre[4][2][2];
#pragma unroll
            for (int m = m0; m < m0 + 2; ++m)
#pragma unroll
                for (int bj = 0; bj < 2; ++bj) { const f32x4* p = (const f32x4*)(x + (size_t)(rowb + ai * 128 + m * 16) * 1024 + colb + bj * 128); pre[m][bj][0] = p[0]; pre[m][bj][1] = p[1]; }
#pragma unroll
            for (int m = m0; m < m0 + 2; ++m)
#pragma unroll
                for (int bj = 0; bj < 2; ++bj) { f32x4* p = (f32x4*)(x + (size_t)(rowb + ai * 128 + m * 16) * 1024 + colb + bj * 128); p[0] = pre[m][bj][0] + acc[ai][bj][m][0]; p[1] = pre[m][bj][1] + acc[ai][bj][m][1]; }
        }
    }
};

struct TailOrder {
    int G, c;
    DI bool next(int i, Unit& u) const { const int j = i * G + c; if (j >= 3 * 4 * NKSL) return false; u.pm = MMAIN / 256 + j / (4 * NKSL); u.pn = (j / NKSL) & 3; const int kh = j % NKSL; u.z = kh; u.offA = (unsigned)(kh * 512); u.offB = (unsigned)(kh * 512); return true; }
    DI void a_ready(const Unit&) const {}
    DI void done(const Unit&) const {}
};
struct EpiPart {
    static constexpr bool PERM = true, AFTER_DRAIN = false;
    float* part;
    DI void operator()(const f32x4 (&acc)[2][2][4][2], const Unit& u, int wr, int wc, int fr, int fq) const {
        const int rowb = u.pm * 256 - MMAIN + wr * 64 + fr, colb = u.pn * 256 + wc * 32 + 8 * fq;
        float* pb = part + (size_t)u.z * (MTOT - MMAIN) * 1024;
#pragma unroll
        for (int ai = 0; ai < 2; ++ai)
#pragma unroll
            for (int m = 0; m < 4; ++m)
#pragma unroll
                for (int bj = 0; bj < 2; ++bj) { f32x4* p = (f32x4*)(pb + (size_t)(rowb + ai * 128 + m * 16) * 1024 + colb + bj * 128); p[0] = acc[ai][bj][m][0]; p[1] = acc[ai][bj][m][1]; }
    }
};

struct EpiSwiglu {
    static constexpr bool PERM = true, AFTER_DRAIN = false;
    bf16_t* hb;
    DI void operator()(const f32x4 (&acc)[2][2][4][2], const Unit& u, int wr, int wc, int fr, int fq) const {
        const int rowb = u.pm * 256 + wr * 64 + fr, colb = u.pn * 128 + wc * 32 + 8 * fq;
#pragma unroll
        for (int ai = 0; ai < 2; ++ai)
#pragma unroll
            for (int m = 0; m < 4; ++m) {
                f32x4 o[2];
#pragma unroll
                for (int n = 0; n < 2; ++n)
#pragma unroll
                    for (int j = 0; j < 4; ++j) o[n][j] = silu(acc[ai][0][m][n][j]) * acc[ai][1][m][n][j];
                *(u32x4*)(hb + (size_t)(rowb + ai * 128 + m * 16) * DFF + colb) = pack8(o[0], o[1]);
            }
    }
};

DI void tr_item(const float* W, int ldw, int K, int k0, int srccol0, bf16_t* WT, int dstrow0, LAS float* scr, int lane) {
#pragma unroll 8
    for (int i = 0; i < 32; ++i) { const int kk = 2 * i + (lane >> 5); scr[kk * 33 + (lane & 31)] = W[(size_t)(k0 + kk) * ldw + srccol0 + (lane & 31)]; }
    asm volatile("s_waitcnt lgkmcnt(0)" ::: "memory");
    const int c = lane & 7;
#pragma unroll
    for (int j = 0; j < 4; ++j) { const int n = (lane >> 3) + 8 * j; const LAS float* s = scr + (8 * c) * 33 + n;
        u32x4 o; o.x = cvt_pk_bf16(s[0 * 33], s[1 * 33]); o.y = cvt_pk_bf16(s[2 * 33], s[3 * 33]); o.z = cvt_pk_bf16(s[4 * 33], s[5 * 33]); o.w = cvt_pk_bf16(s[6 * 33], s[7 * 33]);
        *(u32x4*)(WT + (size_t)(dstrow0 + n) * K + k0 + 8 * c) = o; }
    asm volatile("s_waitcnt lgkmcnt(0)" ::: "memory");
}
DI int win_src(int n) {
    if (n < 512) { const int tile = n >> 8, p = n & 255, a = (p & 127) >> 5, half = p >> 7; return tile * 256 + a * 64 + half * 32; }
    if (n < 2560) return n;
    if (n < 4096) return n + 8;
    return n + 24;
}
DI int wfi_src(int n) { const int pn = n >> 8, p = n & 255; return p < 128 ? 128 * pn + p : DFF + 128 * pn + (p - 128); }

DI void prologue(PARAMS P, LAS unsigned char* lds, int wave, int lane) {
    const int gw = BIDX * 8 + wave, NGW = GDIM * 8, gt = BIDX * NTHREADS + TIDV, NGT = GDIM * NTHREADS;
    LAS float* scr = (LAS float*)(lds + wave * 16384);
    for (int l = 0; l < 2; ++l) {
        bf16_t* wl = (bf16_t*)(P.ws + WS_W) + (size_t)l * WL_END;
        constexpr int I_IN = 16 * 224, I_BR = 8 * 32, I_OUT = 16 * 32, I_FI = 16 * 176, I_FO = 44 * 32, I_M = 2 * 4;
        constexpr int NIT = I_IN + 3 * I_BR + I_OUT + I_FI + I_FO + 12 * I_M;
        for (int it = gw; it < NIT; it += NGW) {
            int r = it;
            if (r < I_IN) { const int kb = r / 224, nb = r % 224; tr_item(P.in[10] + (size_t)l * D * DIN_SRC, DIN_SRC, D, 64 * kb, win_src(32 * nb), wl + WL_WIN, 32 * nb, scr, lane); continue; } r -= I_IN;
            if (r < 3 * I_BR) { const int b = r / I_BR, q = r % I_BR, kb = q / 32, nb = q % 32; tr_item((b == 0 ? P.in[21] : (b == 1 ? P.in[22] : P.in[23])) + (size_t)l * 512 * D, D, 512, 64 * kb, 32 * nb, wl + WL_WBR + (size_t)b * 524288, 32 * nb, scr, lane); continue; } r -= 3 * I_BR;
            if (r < I_OUT) { const int kb = r / 32, nb = r % 32; tr_item(P.in[24] + (size_t)l * D * D, D, D, 64 * kb, 32 * nb, wl + WL_WOUT, 32 * nb, scr, lane); continue; } r -= I_OUT;
            if (r < I_FI) { const int kb = r / 176, nb = r % 176; tr_item(P.in[26] + (size_t)l * D * 2 * DFF, 2 * DFF, D, 64 * kb, wfi_src(32 * nb), wl + WL_WFI, 32 * nb, scr, lane); continue; } r -= I_FI;
            if (r < I_FO) { const int kb = r / 32, nb = r % 32; tr_item(P.in[27] + (size_t)l * DFF * D, D, DFF, 64 * kb, 32 * nb, wl + WL_WFO, 32 * nb, scr, lane); continue; } r -= I_FO;
            { const int mh = r / I_M, q = r % I_M, kb = q / 4, nb = q % 4, mt = mh / 4, hd = mh % 4;
              tr_item((mt == 0 ? P.in[15] : (mt == 1 ? P.in[16] : P.in[17])) + ((size_t)l * 4 + hd) * 16384, 128, 128, 64 * kb, 32 * nb, wl + WL_WM + (size_t)mh * 16384, 32 * nb, scr, lane); }
        }
        float* wsm = (float*)(wl + WL_WSM);
        for (int i = gt; i < 24 * D; i += NGT) { const int j = i >> 10, k = i & 1023; const int src = j < 8 ? 2560 + j : 4104 + (j - 8); wsm[i] = P.in[10][(size_t)l * D * DIN_SRC + (size_t)k * DIN_SRC + src]; }
    }
    float* rot = (float*)(P.ws + WS_ROT);
    for (int i = gt; i < 2128 * 32; i += NGT) { const int pos = i >> 5, k = i & 31; const double inv = exp(-log(10000.0) * (double)k / 31.0), ang = (double)pos * inv; rot[2 * i] = (float)cos(ang); rot[2 * i + 1] = (float)sin(ang); }
    float* X = (float*)(P.ws + WS_X);
    for (int row = gw; row < MTOT; row += NGW) {
        int g = 0, lr = row; if (row >= G0ROWS) { g = 1 + (row - G0ROWS) / GROWS; lr = (row - G0ROWS) % GROWS; }
        const float* src = nullptr;
        if (g != 0 || lr < 8192) src = P.in[0] + ((size_t)(4 * g + (lr >> 11)) * 2048 + (lr & 2047)) * D;
        else if (lr < 8704) src = P.in[1] + (size_t)(lr - 8192) * D;
        else if (lr < 8720) src = P.in[8] + (size_t)(lr - 8704) * D;
        f32x4* dst = (f32x4*)(X + (size_t)row * D);
#pragma unroll
        for (int j = 0; j < 4; ++j) dst[lane + 64 * j] = src ? ((const f32x4*)src)[lane + 64 * j] : (f32x4){0.f, 0.f, 0.f, 0.f};
    }
}

template <int RB> DI void norm_rows(float* X, const f32x4 (&gv)[4], bf16_t* XN, const float* wsm, float* SM, int row0, int lane, const float* part) {
    f32x4 v[RB][4];
#pragma unroll
    for (int r = 0; r < RB; ++r) {
        const int row = row0 + r; const f32x4* xr = (const f32x4*)(X + (size_t)row * D); float ss = 0.f;
#pragma unroll
        for (int j = 0; j < 4; ++j) v[r][j] = xr[lane + 64 * j];
        if (part && row >= MMAIN) {
#pragma unroll 1
            for (int kh = 0; kh < NKSL; ++kh) { const f32x4* pr = (const f32x4*)(part + ((size_t)kh * (MTOT - MMAIN) + (row - MMAIN)) * 1024);
#pragma unroll
                for (int j = 0; j < 4; ++j) v[r][j] += pr[lane + 64 * j]; }
#pragma unroll
            for (int j = 0; j < 4; ++j) ((f32x4*)(X + (size_t)row * D))[lane + 64 * j] = v[r][j];
        }
#pragma unroll
        for (int j = 0; j < 4; ++j) ss += (v[r][j][0] * v[r][j][0] + v[r][j][1] * v[r][j][1]) + (v[r][j][2] * v[r][j][2] + v[r][j][3] * v[r][j][3]);
        const float rs = rsqrtf(wave_sum(ss) * (1.f / D) + EPS);
        u32x2* o = (u32x2*)(XN + (size_t)row * D);
#pragma unroll
        for (int j = 0; j < 4; ++j) { v[r][j] = v[r][j] * rs * gv[j]; u32x2 w; w.x = cvt_pk_bf16(v[r][j][0], v[r][j][1]); w.y = cvt_pk_bf16(v[r][j][2], v[r][j][3]); o[lane + 64 * j] = w; }
    }
    if (wsm) {
        float mine[RB];
#pragma unroll
        for (int r = 0; r < RB; ++r) mine[r] = 0.f;
#pragma unroll 1
        for (int jj = 0; jj < 24; ++jj) {
            const f32x4* wr = (const f32x4*)(wsm + (size_t)jj * D); f32x4 w[4];
#pragma unroll
            for (int j = 0; j < 4; ++j) w[j] = wr[lane + 64 * j];
#pragma unroll
            for (int r = 0; r < RB; ++r) { float p = 0.f;
#pragma unroll
                for (int j = 0; j < 4; ++j) p += (v[r][j][0] * w[j][0] + v[r][j][1] * w[j][1]) + (v[r][j][2] * w[j][2] + v[r][j][3] * w[j][3]);
                p = wave_sum(p); if (lane == jj) mine[r] = p; }
        }
#pragma unroll
        for (int r = 0; r < RB; ++r) if (lane < 32) SM[(size_t)(row0 + r) * 32 + lane] = mine[r];
    }
}
DI void norm_phase(float* X, const float* gain, bf16_t* XN, const float* wsm, float* SM, int wave, int lane, const float* part = nullptr) {
    const int gw = BIDX * 8 + wave, NGW = GDIM * 8;
    f32x4 gv[4];
#pragma unroll
    for (int j = 0; j < 4; ++j) gv[j] = ((const f32x4*)gain)[lane + 64 * j];
    if (wsm) { for (int row0 = gw * 4; row0 < MTOT; row0 += NGW * 4) norm_rows<4>(X, gv, XN, wsm, SM, row0, lane, part); }
    else { for (int row = gw; row < MTOT; row += NGW) norm_rows<1>(X, gv, XN, nullptr, nullptr, row, lane, part); }
}
#ifndef YSCALE
#define YSCALE 1.2f
#endif
DI void final_phase(PARAMS P, int wave, int lane) {
    const int gw = BIDX * 8 + wave, NGW = GDIM * 8;
    const float* X = (const float*)(P.ws + WS_X);
    f32x4 gv[4];
#pragma unroll
    for (int j = 0; j < 4; ++j) gv[j] = ((const f32x4*)P.in[28])[lane + 64 * j];
    for (int row = gw; row < MTOT; row += NGW) {
        int g = 0, lr = row; if (row >= G0ROWS) { g = 1 + (row - G0ROWS) / GROWS; lr = (row - G0ROWS) % GROWS; }
        float* dst;
        if (g != 0 || lr < 8192) dst = P.out + O_YP + ((size_t)(4 * g + (lr >> 11)) * 2048 + (lr & 2047)) * D;
        else if (lr < 8704) dst = P.out + O_YS + (size_t)(lr - 8192) * D;
        else continue;
        const f32x4* xr = (const f32x4*)(X + (size_t)row * D);
        f32x4 v[4]; float ss = 0.f;
#pragma unroll
        for (int j = 0; j < 4; ++j) v[j] = xr[lane + 64 * j];
        if (row >= MMAIN) { const float* part = (const float*)(P.ws + WS_PART);
#pragma unroll 1
            for (int kh = 0; kh < NKSL; ++kh) { const f32x4* pr = (const f32x4*)(part + ((size_t)kh * (MTOT - MMAIN) + (row - MMAIN)) * 1024);
#pragma unroll
                for (int j = 0; j < 4; ++j) v[j] += pr[lane + 64 * j]; } }
#pragma unroll
        for (int j = 0; j < 4; ++j) ss += (v[j][0] * v[j][0] + v[j][1] * v[j][1]) + (v[j][2] * v[j][2] + v[j][3] * v[j][3]);
        const float rs = rsqrtf(wave_sum(ss) * (1.f / D) + EPS);
#pragma unroll
        for (int j = 0; j < 4; ++j) ((f32x4*)dst)[lane + 64 * j] = v[j] * rs * gv[j];
    }
}

constexpr int PL_A = 0, PL_B = 66560, PL_GA = 133120, PL_MI = 137216, PL_MF = 138240, PL_WST = 139264;
DI void prep_phase(PARAMS P, int l, int g, LAS unsigned char* lds, int wave, int lane) {
    const int tid = TIDV;
    bf16_t* gb = (bf16_t*)(P.ws + WS_G);
    const float* SM = (const float*)(P.ws + WS_SM) + (size_t)gbase(g) * 32;
    const bf16_t* wm = (const bf16_t*)(P.ws + WS_W) + (size_t)l * WL_END + WL_WM;
    float* DECG = (float*)(P.ws + WS_DECG); float* MCH = (float*)(P.ws + WS_MCH); float* DN = (float*)(P.ws + WS_DN); f32x4* TS = (f32x4*)(P.ws + WS_TS);
    LAS float* Bl = (LAS float*)(lds + PL_A); LAS bf16_t* Cl = (LAS bf16_t*)(lds + PL_A); LAS bf16_t* Xl = (LAS bf16_t*)(lds + PL_B);
    LAS float* GAl = (LAS float*)(lds + PL_GA); LAS float* MIl = (LAS float*)(lds + PL_MI); LAS float* MFl = (LAS float*)(lds + PL_MF); LAS float* WSTl = (LAS float*)(lds + PL_WST);
    const int nch = g == 0 ? 137 : 128;
    for (int it = BIDX; it < 2 * nch; it += GDIM) {
        const int cid = it >> 1, part = it & 1;
        const int row0 = cid * 64, L = (g == 0 && cid == 136) ? 16 : 64;
        for (int i = tid; i < 64 * 24; i += NTHREADS) { const int t = i / 24, j = i % 24; const float v = SM[(size_t)(row0 + t) * 32 + j];
            if (j < 4) MIl[t * 4 + j] = v; else if (j < 8) MFl[t * 4 + j - 4] = v; else GAl[t * 16 + j - 8] = v; }
        __syncthreads();
        if (part == 0) {
            const int c = tid & 255, half = tid >> 8, tb = 32 * half; float wa[16];
            LAS float* Tl = (LAS float*)(lds + PL_WST + 1024);
#pragma unroll
            for (int r = 0; r < 16; ++r) wa[r] = P.in[19][((size_t)l * 16 + r) * 256 + c];
            const float ba = P.in[20][l * 256 + c]; float b = 0.f;
#pragma unroll 2
            for (int t = tb; t < tb + 32; ++t) { float s = ba;
#pragma unroll
                for (int r = 0; r < 16; ++r) s += GAl[t * 16 + r] * wa[r];
                const float ls = fminf(s, 0.f) - __logf(1.f + __expf(-fabsf(s)));
                b += (t < L) ? ls * (1.f / 16.f) : 0.f; Bl[t * 256 + c] = b; }
            Tl[half * 256 + c] = b;
            __syncthreads();
            const float boff = half ? Tl[c] : 0.f, bl = Tl[c] + Tl[256 + c];
            if (half == 0) DECG[cid * 256 + c] = __expf(bl);
            bf16_t* gq = gb + (size_t)CP_GQ * G0ROWS; bf16_t* gk = gb + (size_t)CP_GK * G0ROWS; bf16_t* ks = gb + (size_t)CP_KSTG * G0ROWS;
#pragma unroll 1
            for (int t0 = tb; t0 < tb + 32; t0 += 8) {
                float qv[8], kv[8];
#pragma unroll
                for (int j = 0; j < 8; ++j) { const size_t o = (size_t)(row0 + t0 + j) * 256 + c; qv[j] = bf2f(gq[o]); kv[j] = bf2f(gk[o]); }
#pragma unroll
                for (int j = 0; j < 8; ++j) { const int t = t0 + j; const float bt = Bl[t * 256 + c] + boff; const size_t o = (size_t)(row0 + t) * 256 + c;
                    gq[o] = f2bf(qv[j] * __expf(bt)); gk[o] = f2bf(kv[j] * __expf(-bt)); ks[o] = f2bf(t < L ? kv[j] * __expf(bl - bt) : 0.f); }
            }
        } else if (part == 1 && wave == 4) {
            const int t = lane;
#pragma unroll
            for (int h = 0; h < 4; ++h) {
                float ig = MIl[t * 4 + h] + P.in[11][l * 4 + h], lf = logsig(MFl[t * 4 + h] + P.in[12][l * 4 + h]);
                if (t >= L) { ig = -INFINITY; lf = 0.f; }
                float b = lf;
#pragma unroll
                for (int d = 1; d < 64; d <<= 1) { const float v = __shfl_up(b, d); if (lane >= d) b += v; }
                const float a = ig - b; float gm = a;
#pragma unroll
                for (int d = 1; d < 64; d <<= 1) { const float v = __shfl_up(gm, d); if (lane >= d) gm = fmaxf(gm, v); }
                const float bl = __shfl(b, 63), mloc = bl + __shfl(gm, 63);
                WSTl[h * 64 + t] = __expf(a + bl - mloc);
                TS[(size_t)(row0 + t) * 4 + h] = (f32x4){a, gm, b, 0.f};
                if (lane == 0) { MCH[(cid * 4 + h) * 2] = bl; MCH[(cid * 4 + h) * 2 + 1] = mloc; }
            }
        }
        __syncthreads();
        if (part == 1) {
        {
            const int ch = tid; const bf16_t* mx = gb + (size_t)CP_MX * G0ROWS; bf16_t* cc = gb + (size_t)CP_CC * G0ROWS;
            const float w0 = P.in[13][((size_t)l * 4 + 0) * 512 + ch], w1 = P.in[13][((size_t)l * 4 + 1) * 512 + ch], w2 = P.in[13][((size_t)l * 4 + 2) * 512 + ch], w3 = P.in[13][((size_t)l * 4 + 3) * 512 + ch], cb = P.in[14][l * 512 + ch];
            float x3, x2, x1;
            const bool is_sample = (g == 0 && cid >= 128 && cid < 136), is_meta = (g == 0 && cid == 136);
            if (is_meta) { x3 = x2 = x1 = 0.f; }
            else if (is_sample) { const float* cs = P.in[6] + ((size_t)(l * 8 + (cid - 128)) * 3) * 512 + ch; x3 = cs[0]; x2 = cs[512]; x1 = cs[1024]; }
            else { const int hr = (cid & 31) ? row0 - 3 : 8704 + 13; x3 = bf2f(mx[(size_t)hr * 512 + ch]); x2 = bf2f(mx[(size_t)(hr + 1) * 512 + ch]); x1 = bf2f(mx[(size_t)(hr + 2) * 512 + ch]); }
#pragma unroll 1
            for (int t0 = 0; t0 < 64; t0 += 8) {
                bf16_t xr[8];
#pragma unroll
                for (int j = 0; j < 8; ++j) xr[j] = mx[(size_t)(row0 + t0 + j) * 512 + ch];
#pragma unroll
                for (int j = 0; j < 8; ++j) { const int t = t0 + j; const bf16_t xb = xr[j]; const float x = bf2f(xb);
                    const float cv = silu(cb + w0 * x3 + w1 * x2 + w2 * x1 + w3 * x); const bf16_t cbf = f2bf(cv);
                    Cl[t * 520 + ch] = cbf; Xl[t * 520 + ch] = xb; cc[(size_t)(row0 + t) * 512 + ch] = cbf;
                    x3 = x2; x2 = x1; x1 = x; }
            }
            if (is_sample) { float* o = P.out + O_SCONV + ((size_t)(l * 8 + (cid - 128)) * 3) * 512 + ch; o[0] = x3; o[512] = x2; o[1024] = x1; }
            else if (!is_meta && (cid & 31) == 31) { float* o = P.out + O_PCONV + ((size_t)(l * 16 + 4 * g + (cid >> 5)) * 3) * 512 + ch; o[0] = x3; o[512] = x2; o[1024] = x1; }
        }
        __syncthreads();
        {
            const int r = lane & 31, hh = lane >> 5;
#pragma unroll 1
            for (int cbk = wave * 6; cbk < wave * 6 + 6; ++cbk) {
                const int mt = cbk >> 4, hd = (cbk >> 2) & 3, nb = cbk & 3;
                const bf16_t* wt = wm + (size_t)(mt * 4 + hd) * 16384 + (size_t)(32 * nb + r) * 128 + 8 * hh;
                const LAS bf16_t* al = (mt == 2 ? Xl : Cl) + r * 520 + hd * 128 + 8 * hh;
                f32x16 a0, a1;
#pragma unroll
                for (int i = 0; i < 16; ++i) { a0[i] = 0.f; a1[i] = 0.f; }
#pragma unroll
                for (int ks = 0; ks < 8; ++ks) {
                    const bf16x8 b = *(const bf16x8*)(wt + 16 * ks);
                    const bf16x8 x0 = *(const LAS bf16x8*)(al + 16 * ks), x1 = *(const LAS bf16x8*)(al + 32 * 520 + 16 * ks);
                    a0 = MFMA32(x0, b, a0); a1 = MFMA32(x1, b, a1);
                }
                const int e = hd * 128 + 32 * nb + r;
                if (mt == 1) {
                    bf16_t* mk = gb + (size_t)CP_MK * G0ROWS; bf16_t* mks = gb + (size_t)CP_MKST * G0ROWS; float dn = 0.f;
#pragma unroll
                    for (int i = 0; i < 16; ++i) {
                        int t0 = crow(i, hh); asm volatile("" : "+v"(t0)); const int t1 = 32 + t0; const float k0 = a0[i] * 0.08838834764831845f, k1 = a1[i] * 0.08838834764831845f;
                        const float w0 = WSTl[hd * 64 + t0], w1 = WSTl[hd * 64 + t1];
                        mk[(size_t)(row0 + t0) * 512 + e] = f2bf(k0); mk[(size_t)(row0 + t1) * 512 + e] = f2bf(k1);
                        mks[(size_t)(row0 + t0) * 512 + e] = f2bf(k0 * w0); mks[(size_t)(row0 + t1) * 512 + e] = f2bf(k1 * w1);
                        dn += k0 * w0 + k1 * w1;
                    }
                    dn += __shfl_xor(dn, 32);
                    if (hh == 0) DN[(size_t)(cid * 4 + hd) * 128 + 32 * nb + r] = dn;
                } else {
                    bf16_t* o = gb + (size_t)(mt == 0 ? CP_MQ : CP_MV) * G0ROWS;
#pragma unroll
                    for (int i = 0; i < 16; ++i) { int t0 = crow(i, hh); asm volatile("" : "+v"(t0)); o[(size_t)(row0 + t0) * 512 + e] = f2bf(a0[i]); o[(size_t)(row0 + 32 + t0) * 512 + e] = f2bf(a1[i]); }
                }
            }
        }
        }
        __syncthreads();
    }
}

#ifndef PRECH
#define PRECH 136
#endif
template <int BR> DI void scan_item(PARAMS P, int l, int g, int seq, int h, int vs, int ct, int lane, LAS unsigned char* wlds) {
    constexpr int DK = BR == 1 ? 128 : 64, KW = BR == 1 ? 512 : 256;
    const int r = lane & 31, hh = lane >> 5;
    const bf16_t* gb = (const bf16_t*)(P.ws + WS_G);
    const bf16_t* KST = gb + (size_t)(BR == 0 ? CP_KSTR : (BR == 1 ? CP_MKST : CP_KSTG)) * G0ROWS + h * DK + r;
    const bf16_t* V = gb + (size_t)(BR == 0 ? CP_RV : (BR == 1 ? CP_MV : CP_GV)) * G0ROWS + h * 128 + 32 * vs + r;
    bf16_t* SP = (bf16_t*)((unsigned char*)P.out + (BR == 0 ? DS_SPR : (BR == 1 ? DS_SPM : DS_SPG)));
    const float* DECG = (const float*)(P.ws + WS_DECG); const float* MCH = (const float*)(P.ws + WS_MCH); const float* DN = (const float*)(P.ws + WS_DN);
    float* NPv = (float*)(P.ws + WS_NP); float* MPv = (float*)(P.ws + WS_MP);
    int pre = -1, c0, nch = 1; const float* s0 = nullptr; float* fin = nullptr; int sidx = 0; bool sample = false;
    if (seq < 4) { pre = PRECH; c0 = 32 * seq; nch = 32; sidx = l * 16 + 4 * g + seq;
        fin = P.out + (BR == 0 ? O_PRET : (BR == 1 ? O_PC : O_PGLA)) + ((size_t)sidx * 4 + h) * DK * 128; }
    else if (seq < 12) { sample = true; c0 = 128 + (seq - 4); sidx = l * 8 + (seq - 4);
        s0 = P.in[BR == 0 ? 2 : (BR == 1 ? 3 : 7)] + ((size_t)sidx * 4 + h) * DK * 128;
        fin = P.out + (BR == 0 ? O_SRET : (BR == 1 ? O_SC : O_SGLA)) + ((size_t)sidx * 4 + h) * DK * 128; }
    else { c0 = 136; }
    f32x16 S;
#pragma unroll
    for (int i = 0; i < 16; ++i) S[i] = s0 ? s0[(size_t)(32 * ct + crow(i, hh)) * 128 + 32 * vs + r] : 0.f;
    const bool own_n = (BR == 1 && vs == 0 && ct == 0);
    float m = 0.f, n0 = 0.f, n1 = 0.f;
    if (BR == 1 && sample) { m = P.in[5][sidx * 4 + h]; n0 = P.in[4][((size_t)sidx * 4 + h) * 128 + lane]; n1 = P.in[4][((size_t)sidx * 4 + h) * 128 + 64 + lane]; }
    const float lg = lg2gamma(h);
    const bf16_t* KSTb = KST - r; const bf16_t* Vb = V - r;
    LAS bf16_t* Atl = (LAS bf16_t*)wlds; LAS bf16_t* Btl = (LAS bf16_t*)(wlds + 5120);
#define SCAN_LOAD(AF, BF, CID) do { const int r0_ = (CID) * 64; _Pragma("unroll") for (int k = 0; k < 4; ++k) { const int id_ = lane + 64 * k, rw_ = id_ >> 2, q_ = id_ & 3; \
        AF[k] = *(const u32x4*)(KSTb + (size_t)(r0_ + rw_) * KW + 32 * ct + 8 * q_); BF[k] = *(const u32x4*)(Vb + (size_t)(r0_ + rw_) * 512 + 8 * q_); } } while (0)
#define SCAN_LOAD_DEC(DV, BLV, MLV, D0, D1, CID) do { if (BR == 2) { _Pragma("unroll") for (int i = 0; i < 16; ++i) DV[i] = DECG[(CID) * 256 + h * 64 + 32 * ct + crow(i, hh)]; } \
        if (BR == 1) { BLV = MCH[((CID) * 4 + h) * 2]; MLV = MCH[((CID) * 4 + h) * 2 + 1]; if (own_n) { D0 = DN[(size_t)((CID) * 4 + h) * 128 + lane]; D1 = DN[(size_t)((CID) * 4 + h) * 128 + 64 + lane]; } } } while (0)
    u32x4 an[4], bn[4]; float decn[16], bln = 0.f, mln = 0.f, dn0n = 0.f, dn1n = 0.f;
#pragma unroll
    for (int i = 0; i < 16; ++i) decn[i] = 1.f;
    int cidn = pre >= 0 ? pre : c0;
    SCAN_LOAD(an, bn, cidn); SCAN_LOAD_DEC(decn, bln, mln, dn0n, dn1n, cidn);
    for (int ci = (pre >= 0 ? -1 : 0); ci < nch; ++ci) {
        const int cid = cidn;
        u32x4 ta[4], tb[4];
#pragma unroll
        for (int k = 0; k < 4; ++k) { ta[k] = an[k]; tb[k] = bn[k]; }
        float decc[16]; const float blc = bln, mlc = mln, dn0c = dn0n, dn1c = dn1n;
#pragma unroll
        for (int i = 0; i < 16; ++i) decc[i] = decn[i];
        if (ci + 1 < nch) { cidn = c0 + ci + 1; SCAN_LOAD(an, bn, cidn); SCAN_LOAD_DEC(decn, bln, mln, dn0n, dn1n, cidn); }
        asm volatile("s_waitcnt lgkmcnt(0)" ::: "memory");
#pragma unroll
        for (int k = 0; k < 4; ++k) { const int id_ = lane + 64 * k, rw_ = id_ >> 2, q_ = id_ & 3; *(LAS u32x4*)(Atl + rw_ * 40 + 8 * q_) = ta[k]; *(LAS u32x4*)(Btl + rw_ * 40 + 8 * q_) = tb[k]; }
        asm volatile("s_waitcnt lgkmcnt(0)" ::: "memory");
        bf16x8 ac[4], bc[4];
        {
            typedef short s16x4_t __attribute__((ext_vector_type(4)));
            const unsigned lo_ = (unsigned)((8 * hh + ((lane & 15) >> 2)) * 80 + (16 * ((lane >> 4) & 1) + 4 * (lane & 3)) * 2);
            const unsigned aad = (unsigned)(size_t)Atl + lo_, bad = (unsigned)(size_t)Btl + lo_;
            s16x4_t al_[4], ah_[4], bl_[4], bh_[4];
#pragma unroll
            for (int ks = 0; ks < 4; ++ks) {
                asm volatile("ds_read_b64_tr_b16 %0, %1 offset:%c2" : "=&v"(al_[ks]) : "v"(aad), "i"(ks * 1280) : "memory");
                asm volatile("ds_read_b64_tr_b16 %0, %1 offset:%c2" : "=&v"(ah_[ks]) : "v"(aad), "i"(ks * 1280 + 320) : "memory");
                asm volatile("ds_read_b64_tr_b16 %0, %1 offset:%c2" : "=&v"(bl_[ks]) : "v"(bad), "i"(ks * 1280) : "memory");
                asm volatile("ds_read_b64_tr_b16 %0, %1 offset:%c2" : "=&v"(bh_[ks]) : "v"(bad), "i"(ks * 1280 + 320) : "memory");
            }
            asm volatile("s_waitcnt lgkmcnt(0)" ::: "memory");
#pragma unroll
            for (int ks = 0; ks < 4; ++ks) { ac[ks] = __builtin_shufflevector(al_[ks], ah_[ks], 0, 1, 2, 3, 4, 5, 6, 7); bc[ks] = __builtin_shufflevector(bl_[ks], bh_[ks], 0, 1, 2, 3, 4, 5, 6, 7); }
        }
        if (ci >= 0) {
            bf16_t* sp = SP + (size_t)(cid * 4 + h) * 128 * DK + (size_t)((ct * 4) * 2 + hh) * 512 + (size_t)(32 * vs + r) * 4;
#pragma unroll
            for (int q4 = 0; q4 < 4; ++q4) { u32x2 w; w.x = cvt_pk_bf16(S[4 * q4], S[4 * q4 + 1]); w.y = cvt_pk_bf16(S[4 * q4 + 2], S[4 * q4 + 3]); *(u32x2*)(sp + q4 * 1024) = w; }
            if (own_n) { NPv[(size_t)(cid * 4 + h) * 128 + lane] = n0; NPv[(size_t)(cid * 4 + h) * 128 + 64 + lane] = n1; if (lane == 0) MPv[cid * 4 + h] = m; }
        }
        float so = 1.f, sn = 1.f;
        if (BR == 0) so = exp2f((float)((cid == 136) ? 16 : 64) * lg);
        if (BR == 1) { const float bl = blc, ml = mlc; const float mn = fmaxf(bl + m, ml); so = __expf(bl + m - mn); sn = __expf(ml - mn); m = mn;
            n0 = so * n0 + sn * dn0c; n1 = so * n1 + sn * dn1c; }
        {
            f32x16 ds;
#pragma unroll
            for (int i = 0; i < 16; ++i) ds[i] = 0.f;
#pragma unroll
            for (int ks = 0; ks < 4; ++ks) ds = MFMA32(ac[ks], bc[ks], ds);
            if (BR == 2) {
#pragma unroll
                for (int i = 0; i < 16; ++i) S[i] = decc[i] * S[i] + ds[i];
            } else {
#pragma unroll
                for (int i = 0; i < 16; ++i) S[i] = so * S[i] + sn * ds[i];
            }
        }
    }
#undef SCAN_LOAD
#undef SCAN_LOAD_DEC
    if (fin) {
#pragma unroll
        for (int i = 0; i < 16; ++i) fin[(size_t)(32 * ct + crow(i, hh)) * 128 + 32 * vs + r] = S[i];
        if (own_n) {
            float* on = P.out + (sample ? O_SN : O_PN) + ((size_t)sidx * 4 + h) * 128; on[lane] = n0; on[64 + lane] = n1;
            if (lane == 0) P.out[(sample ? O_SMM : O_PM) + sidx * 4 + h] = m;
        }
    }
}
DI void scan_phase(PARAMS P, int l, int g, LAS unsigned char* lds, int wave, int lane) {
    LAS unsigned char* wlds = lds + wave * 10240;
    const int nseq = g == 0 ? 13 : 4, nitems = nseq * 128;
    const bool swz = ((int)GDIM == 256);
    for (int slot = BIDX + GDIM * wave; slot < (swz ? 2048 : nitems); slot += GDIM * 8) {
        int it = slot;
        if (swz) { const int b_ = slot & 255, w_ = slot >> 8, xcd_ = b_ & 7, q_ = w_ * 32 + (b_ >> 3); it = (((q_ >> 3) * 8 + xcd_) << 3) + (q_ & 7); if (it >= nitems) continue; }
        const int sh = it >> 5, local = it & 31, seq = sh >> 2, h = sh & 3;
        if (local < 8) scan_item<0>(P, l, g, seq, h, local & 3, local >> 2, lane, wlds);
        else if (local < 24) scan_item<1>(P, l, g, seq, h, (local - 8) & 3, (local - 8) >> 2, lane, wlds);
        else scan_item<2>(P, l, g, seq, h, (local - 24) & 3, (local - 24) >> 2, lane, wlds);
    }
}

constexpr int OL_P = 0, OL_O = 9216, OL_TS = 43008;
template <int BR> DI void out_item(PARAMS P, int l, int cid, int h, LAS unsigned char* lds, int wave, int lane) {
    constexpr int DK = BR == 1 ? 128 : 64, NKS = DK / 16, QW = BR == 1 ? 512 : 256;
    const int tid = TIDV, r = lane & 31, hh = lane >> 5, tt = wave >> 2, vt = wave & 3, row0 = cid * 64;
    const bf16_t* gb = (const bf16_t*)(P.ws + WS_G);
    const bf16_t* Q = gb + (size_t)(BR == 0 ? CP_QINR : (BR == 1 ? CP_MQ : CP_GQ)) * G0ROWS + (size_t)row0 * QW + h * DK;
    const bf16_t* K = gb + (size_t)(BR == 0 ? CP_KINR : (BR == 1 ? CP_MK : CP_GK)) * G0ROWS + (size_t)row0 * QW + h * DK;
    const bf16_t* V = gb + (size_t)(BR == 0 ? CP_RV : (BR == 1 ? CP_MV : CP_GV)) * G0ROWS + (size_t)row0 * 512 + h * 128;
    const bf16_t* GT = gb + (size_t)(BR == 0 ? CP_RG : (BR == 1 ? CP_MZ : CP_GR)) * G0ROWS + (size_t)row0 * 512 + h * 128;
    const bf16_t* ST = (const bf16_t*)((const unsigned char*)P.out + (BR == 0 ? DS_SPR : (BR == 1 ? DS_SPM : DS_SPG))) + (size_t)(cid * 4 + h) * 128 * DK;
    bf16_t* OB = (bf16_t*)((unsigned char*)P.out + DS_OB) + (size_t)BR * G0ROWS * 512 + (size_t)row0 * 512 + h * 128;
    LAS bf16_t* Pl = (LAS bf16_t*)(lds + OL_P); LAS float* Ol = (LAS float*)(lds + OL_O); LAS float* Al = (LAS float*)(lds + OL_TS); LAS float* Gl = Al + 64; LAS float* Bl = Al + 128;
    float mp = 0.f;
    if (BR == 1) {
        mp = ((const float*)(P.ws + WS_MP))[cid * 4 + h];
        if (tid < 64) { const f32x4 ts = ((const f32x4*)(P.ws + WS_TS))[(size_t)(row0 + tid) * 4 + h]; Al[tid] = ts[0]; Gl[tid] = ts[1]; Bl[tid] = ts[2]; }
        __syncthreads();
    }
    f32x16 o;
#pragma unroll
    for (int i = 0; i < 16; ++i) o[i] = 0.f;
#pragma unroll
    for (int ks = 0; ks < NKS; ++ks) {
        const bf16x8 a = *(const bf16x8*)(Q + (size_t)(32 * tt + r) * QW + 16 * ks + 8 * hh);
        typedef short s16x4_o __attribute__((ext_vector_type(4)));
        const bf16_t* stp = ST + (size_t)((((ks >> 1) * 4 + 2 * (ks & 1) + hh) * 2) * 128 + 32 * vt + r) * 4;
        const s16x4_o b0_ = *(const s16x4_o*)stp, b1_ = *(const s16x4_o*)(stp + 512);
        const bf16x8 b = __builtin_shufflevector(b0_, b1_, 0, 1, 2, 3, 4, 5, 6, 7);
        o = MFMA32(a, b, o);
    }
    if (BR == 1) {
#pragma unroll
        for (int i = 0; i < 16; ++i) o[i] *= __expf(mp - fmaxf(mp, Gl[32 * tt + crow(i, hh)]));
    }
    if (wave < 4) {
        const int ts = wave >> 1, ss = wave & 1; f32x16 p;
#pragma unroll
        for (int i = 0; i < 16; ++i) p[i] = 0.f;
        if (ss <= ts) {
#pragma unroll
            for (int ks = 0; ks < NKS; ++ks) {
                const bf16x8 a = *(const bf16x8*)(Q + (size_t)(32 * ts + r) * QW + 16 * ks + 8 * hh), b = *(const bf16x8*)(K + (size_t)(32 * ss + r) * QW + 16 * ks + 8 * hh);
                p = MFMA32(a, b, p);
            }
        }
        const int s = 32 * ss + r; float as = 0.f; if (BR == 1) as = Al[s];
#pragma unroll
        for (int i = 0; i < 16; ++i) { const int t = 32 * ts + crow(i, hh); float v = 0.f;
            if (s <= t) { v = p[i]; if (BR == 1) v *= __expf(as - fmaxf(mp, Gl[t])); }
            Pl[t * 72 + s] = f2bf(v); }
    }
    __syncthreads();
#pragma unroll
    for (int ks = 0; ks < 4; ++ks) {
        const bf16x8 a = *(const LAS bf16x8*)(Pl + (32 * tt + r) * 72 + 16 * ks + 8 * hh); bf16x8 b;
#pragma unroll
        for (int j = 0; j < 8; ++j) b[j] = (short)V[(size_t)(16 * ks + 8 * hh + j) * 512 + 32 * vt + r];
        o = MFMA32(a, b, o);
    }
#pragma unroll
    for (int i = 0; i < 16; ++i) Ol[(32 * tt + crow(i, hh)) * 132 + 32 * vt + r] = o[i];
    __syncthreads();
    {
        const int t = tid >> 3, seg = tid & 7; float ov[16];
#pragma unroll
        for (int e = 0; e < 16; ++e) ov[e] = Ol[t * 132 + 16 * seg + e];
        const bf16_t* gp = GT + (size_t)t * 512 + 16 * seg;
        f32x4 g0, g1, g2, g3; unpack8(*(const u32x4*)gp, g0, g1); unpack8(*(const u32x4*)(gp + 8), g2, g3);
        const float gate[16] = {g0[0], g0[1], g0[2], g0[3], g1[0], g1[1], g1[2], g1[3], g2[0], g2[1], g2[2], g2[3], g3[0], g3[1], g3[2], g3[3]};
        float outv[16];
        if (BR == 1) {
            float ps = 0.f;
#pragma unroll
            for (int e = 0; e < 8; ++e) ps += bf2f(Pl[t * 72 + 8 * seg + e]);
            const float* np = (const float*)(P.ws + WS_NP) + (size_t)(cid * 4 + h) * 128 + 16 * seg; const bf16_t* qp = Q + (size_t)t * QW + 16 * seg; float qn = 0.f;
#pragma unroll
            for (int e = 0; e < 16; ++e) qn += bf2f(qp[e]) * np[e];
            ps += __shfl_xor(ps, 1); ps += __shfl_xor(ps, 2); ps += __shfl_xor(ps, 4);
            qn += __shfl_xor(qn, 1); qn += __shfl_xor(qn, 2); qn += __shfl_xor(qn, 4);
            const float mg = fmaxf(mp, Gl[t]), den = ps + __expf(mp - mg) * qn, mt = Bl[t] + mg, dd = fmaxf(fabsf(den), __expf(-mt)), inv = 1.f / dd;
#pragma unroll
            for (int e = 0; e < 16; ++e) ov[e] *= inv;
        }
        float sq = 0.f;
#pragma unroll
        for (int e = 0; e < 16; ++e) sq += ov[e] * ov[e];
        sq += __shfl_xor(sq, 1); sq += __shfl_xor(sq, 2); sq += __shfl_xor(sq, 4);
        const float rs = rsqrtf(sq * (1.f / 128.f) + EPS);
        if (BR == 1) {
            const bf16_t* cp = gb + (size_t)CP_CC * G0ROWS + (size_t)(row0 + t) * 512 + h * 128 + 16 * seg; const float* sk = P.in[18] + l * 512 + h * 128 + 16 * seg;
#pragma unroll
            for (int e = 0; e < 16; ++e) outv[e] = gate[e] * (ov[e] * rs + sk[e] * bf2f(cp[e]));
        } else {
#pragma unroll
            for (int e = 0; e < 16; ++e) outv[e] = ov[e] * rs * gate[e];
        }
        u32x4 w0, w1;
        w0.x = cvt_pk_bf16(outv[0], outv[1]); w0.y = cvt_pk_bf16(outv[2], outv[3]); w0.z = cvt_pk_bf16(outv[4], outv[5]); w0.w = cvt_pk_bf16(outv[6], outv[7]);
        w1.x = cvt_pk_bf16(outv[8], outv[9]); w1.y = cvt_pk_bf16(outv[10], outv[11]); w1.z = cvt_pk_bf16(outv[12], outv[13]); w1.w = cvt_pk_bf16(outv[14], outv[15]);
        bf16_t* op = OB + (size_t)t * 512 + 16 * seg; *(u32x4*)op = w0; *(u32x4*)(op + 8) = w1;
    }
    __syncthreads();
}
DI void out_phase(PARAMS P, int l, int g, LAS unsigned char* lds, int wave, int lane) {
    const int nch = g == 0 ? 137 : 128, nitems = nch * 12;
    for (int it = BIDX; it < nitems; it += GDIM) {
        const int h = it & 3, q = it >> 2, br = q % 3, cid = q / 3;
        if (br == 0) out_item<0>(P, l, cid, h, lds, wave, lane); else if (br == 1) out_item<1>(P, l, cid, h, lds, wave, lane); else out_item<2>(P, l, cid, h, lds, wave, lane);
    }
}

#define XB_TMO      128
#define XB_XCNT(j)  (256  + 64 * (j))
#define XB_XSUB(j)  (1280 + 64 * (j))
#define XB_XGEN(j)  (2304 + 64 * (j))
#define XB_TOP      3328
#define XB_TOPGEN   3392
#define XCD_BAR_WORDS 3456
#define XB_SPIN_CAP (1u << 18)

__device__ __forceinline__ unsigned xb_ld(unsigned* p)              { return __hip_atomic_load(p, __ATOMIC_RELAXED, __HIP_MEMORY_SCOPE_AGENT); }
__device__ __forceinline__ unsigned xb_add(unsigned* p, unsigned v) { return __hip_atomic_fetch_add(p, v, __ATOMIC_RELAXED, __HIP_MEMORY_SCOPE_AGENT); }
__device__ __forceinline__ unsigned xb_xcc_id() { return (unsigned)__builtin_amdgcn_s_getreg((3 << 11) | 20) & 0xFu; }
#define XB_SPIN(cond, bar) do { unsigned _sp = 0; while (cond) { __builtin_amdgcn_s_sleep(1); \
    if ((++_sp & 255u) == 0u) { if (xb_ld(&(bar)[XB_TMO])) break; if (_sp > XB_SPIN_CAP) { atomicAdd(&(bar)[XB_TMO], 1u); break; } } } } while (0)

struct XcdBarrier {
    unsigned* bar; unsigned x;
    volatile LAS unsigned* st;
};

__device__ __forceinline__ XcdBarrier xcd_barrier_post(unsigned* bar, volatile LAS unsigned* st) {
    XcdBarrier b; b.bar = bar; b.x = xb_xcc_id(); b.st = st;
    if (threadIdx.x == 0) (void)xb_add(&bar[XB_XCNT(b.x)], 1u);
    return b;
}
__device__ __forceinline__ void xcd_barrier_complete(unsigned* bar, unsigned x, unsigned& nloc, unsigned& nx) {
    const unsigned G = gridDim.x * gridDim.y * gridDim.z;
    unsigned sum, cnt, mine, sp = 0u;
    for (;;) {
        sum = 0u; cnt = 0u; mine = 0u;
#pragma unroll
        for (unsigned j = 0; j < 16; ++j) { const unsigned c = xb_ld(&bar[XB_XCNT(j)]); sum += c; cnt += (c > 0u) ? 1u : 0u; mine = (j == x) ? c : mine; }
        if (sum == G) break;
        __builtin_amdgcn_s_sleep(1);
        if ((++sp & 255u) == 0u) { if (xb_ld(&bar[XB_TMO])) break; if (sp > XB_SPIN_CAP) { atomicAdd(&bar[XB_TMO], 1u); break; } }
    }
    nloc = mine > 0u ? mine : 1u; nx = cnt > 0u ? cnt : 1u;
}

__device__ __forceinline__ void xcd_barrier(const XcdBarrier& b) {
    asm volatile("s_waitcnt vmcnt(0)" ::: "memory");
    __syncthreads();
    if (threadIdx.x == 0) {
        unsigned* bar = b.bar;
        __builtin_amdgcn_s_waitcnt(0);
        unsigned nloc = b.st[0], nx = b.st[1];
        if (nloc == 0u) { xcd_barrier_complete(bar, b.x, nloc, nx); b.st[0] = nloc; b.st[1] = nx; }
        const unsigned old = xb_add(&bar[XB_XSUB(b.x)], 1u);
        const unsigned gen = old / nloc;
        if (old + 1u == (gen + 1u) * nloc) {
            __builtin_amdgcn_fence(__ATOMIC_RELEASE, "agent");
            asm volatile("s_waitcnt vmcnt(0)" ::: "memory");
            const unsigned og = xb_add(&bar[XB_TOP], 1u);
            const unsigned tg = og / nx;
            if (og + 1u == (tg + 1u) * nx) xb_add(&bar[XB_TOPGEN], 1u);
            else XB_SPIN(xb_ld(&bar[XB_TOPGEN]) == tg, bar);
            __builtin_amdgcn_fence(__ATOMIC_ACQUIRE, "agent");
            xb_add(&bar[XB_XGEN(b.x)], 1u);
            asm volatile("s_waitcnt vmcnt(0)" ::: "memory");
        } else {
            XB_SPIN(xb_ld(&bar[XB_XGEN(b.x)]) == gen, bar);
            __builtin_amdgcn_fence(__ATOMIC_ACQUIRE, "agent");
            asm volatile("s_waitcnt vmcnt(0)" ::: "memory");
        }
    }
    __syncthreads();
}

#ifndef PHMASK
#define PHMASK 0xFFFF
#endif
#ifndef MK_SINGLE
#define MK_SINGLE 1
#endif
constexpr int NPHASE = 52;
DI void phase_decode(int ph, int& kind, int& l, int& g) {
    l = 0; g = 0;
    if (ph == 0) kind = 0; else if (ph == NPHASE - 1) kind = 11;
    else { const int q = ph - 1; l = q / 25; const int r = q % 25;
        if (r == 0) kind = 1; else if (r == 1) kind = 2; else if (r >= 22) kind = 8 + (r - 22); else { g = (r - 2) / 5; kind = 3 + (r - 2) % 5; } }
}
template <int KIND> DI void run_phase(PARAMS P, int l, int g) {
    extern __shared__ __attribute__((aligned(16))) unsigned char lds_raw[];
    LAS unsigned char* lds = (LAS unsigned char*)lds_raw;
    const int lane = TIDV & 63, wave = __builtin_amdgcn_readfirstlane(TIDV >> 6);
    const bf16_t* wl = (const bf16_t*)(P.ws + WS_W) + (size_t)l * WL_END;
    float* X = (float*)(P.ws + WS_X); bf16_t* XN = (bf16_t*)(P.ws + WS_XN); bf16_t* gb = (bf16_t*)(P.ws + WS_G);
    const int gr = grows(g), gbs = gbase(g);
    if constexpr (KIND == 0) prologue(P, lds, wave, lane);
    else if constexpr (KIND == 1) norm_phase(X, P.in[9] + l * D, XN, (const float*)(wl + WL_WSM), (float*)(P.ws + WS_SM), wave, lane, l > 0 ? (const float*)(P.ws + WS_PART) : nullptr);
    else if constexpr (KIND == 2) { pg8::Gemm gm{XN + (size_t)gbs * D, wl + WL_WIN, gr, NIN, D}; pg8::StaticOrder S; S.init(gr, NIN, GDIM, BIDX);
        EpiIn E{gb, (const float*)(P.ws + WS_ROT), g}; pg8::gemm_phase<EpiIn, pg8::StaticOrder, true, true>(TIDV, lds, gm, S, E); }
    else if constexpr (KIND == 3) prep_phase(P, l, g, lds, wave, lane);
    else if constexpr (KIND == 4) scan_phase(P, l, g, lds, wave, lane);
    else if constexpr (KIND == 5) out_phase(P, l, g, lds, wave, lane);
    else if constexpr (KIND == 6) {
        pg8::Gemm gm{(const bf16_t*)((unsigned char*)P.out + DS_OB), wl + WL_WBR, gr, D, 512};
        BrOrder S; S.S.init(gr, D, GDIM, BIDX);
        EpiBr E{gb + (size_t)CP_ZG * G0ROWS, (float*)((unsigned char*)P.out + DS_MIXF), (bf16_t*)((unsigned char*)P.out + DS_MIXB)};
        pg8::gemm_phase<EpiBr, BrOrder, true, true>(TIDV, lds, gm, S, E); }
    else if constexpr (KIND == 7) {
        { pg8::Gemm gm{(const bf16_t*)((unsigned char*)P.out + DS_MIXB), wl + WL_WOUT, gr, D, D}; pg8::StaticOrder S; S.init(gr, D, GDIM, GDIM - 1 - BIDX);
          EpiRes E{X + (size_t)gbs * D}; pg8::gemm_phase<EpiRes, pg8::StaticOrder, true, true>(TIDV, lds, gm, S, E); }
        if (g < NGROUP - 1) { const int g2 = g + 1, gr2 = grows(g2), gbs2 = gbase(g2);
          pg8::Gemm gm{XN + (size_t)gbs2 * D, wl + WL_WIN, gr2, NIN, D}; pg8::StaticOrder S; S.init(gr2, NIN, GDIM, BIDX);
          EpiIn E{gb, (const float*)(P.ws + WS_ROT), g2}; pg8::gemm_phase<EpiIn, pg8::StaticOrder, true, true>(TIDV, lds, gm, S, E); }
    }
    else if constexpr (KIND == 8) norm_phase(X, P.in[25] + l * D, XN, nullptr, nullptr, wave, lane);
    else if constexpr (KIND == 9) { pg8::Gemm gm{XN, wl + WL_WFI, MTOT, 2 * DFF, D}; pg8::StaticOrder S; S.init(MTOT, 2 * DFF, GDIM, BIDX);
        EpiSwiglu E{gb}; pg8::gemm_phase<EpiSwiglu, pg8::StaticOrder, true, true>(TIDV, lds, gm, S, E); }
    else if constexpr (KIND == 10) {
        { pg8::Gemm gm{gb, wl + WL_WFO, MMAIN, D, DFF}; pg8::StaticOrder S; S.init(MMAIN, D, GDIM, BIDX); EpiRes E{X}; pg8::gemm_phase<EpiRes, pg8::StaticOrder, true, true>(TIDV, lds, gm, S, E); }
        { pg8::Gemm gm{gb, wl + WL_WFO, MTOT, D, 256, DFF}; TailOrder T{(int)GDIM, (int)BIDX}; EpiPart E{(float*)(P.ws + WS_PART)}; pg8::gemm_phase<EpiPart, TailOrder, false, false>(TIDV, lds, gm, T, E); }
    }
    else final_phase(P, wave, lane);
}
#define KARG const __attribute__((address_space(4))) Params* Pp = (const __attribute__((address_space(4))) Params*)__builtin_amdgcn_kernarg_segment_ptr(); asm volatile("" : "+s"(Pp)); PARAMS P = *Pp;
#if MK_SINGLE
__global__ void __launch_bounds__(NTHREADS, 2) fwd_kernel(Params P_) {
    cg::grid_group grid = cg::this_grid();
    extern __shared__ __attribute__((aligned(16))) unsigned char lds_k[];
    volatile LAS unsigned* bst = (volatile LAS unsigned*)((LAS unsigned char*)lds_k + LDS_BYTES - 64);
    if (threadIdx.x < 2) bst[threadIdx.x] = 0u;
    __syncthreads();
    const XcdBarrier bar = xcd_barrier_post((unsigned*)(P_.ws + WS_BAR), bst);
    const int hi = P_.hi < NPHASE ? P_.hi : NPHASE;
    int ph0 = P_.lo;
    if (ph0 == 0) {
        { KARG if (PHMASK & 1) run_phase<0>(P, 0, 0); }
        ph0 = 1;
        if (ph0 < hi) grid.sync();
    }
    for (int ph = ph0; ph < hi; ++ph) {
        KARG
        int kind, l, g; phase_decode(ph, kind, l, g);
        switch (kind) {
        case 1: if (PHMASK & 2) run_phase<1>(P, l, g); break;
        case 2: if (PHMASK & 4) run_phase<2>(P, l, g); break;
        case 3: if (PHMASK & 8) run_phase<3>(P, l, g); break;
        case 4: if (PHMASK & 16) run_phase<4>(P, l, g); break;
        case 5: if (PHMASK & 32) run_phase<5>(P, l, g); break;
        case 6: if (PHMASK & 64) run_phase<6>(P, l, g); break;
        case 7: if (PHMASK & 128) run_phase<7>(P, l, g); break;
        case 8: if (PHMASK & 256) run_phase<8>(P, l, g); break;
        case 9: if (PHMASK & 512) run_phase<9>(P, l, g); break;
        case 10: if (PHMASK & 1024) run_phase<10>(P, l, g); break;
        default: if (PHMASK & 2048) run_phase<11>(P, l, g); break;
        }
        if (ph + 1 < hi) xcd_barrier(bar);
    }
}
#else
template <int KIND> __global__ void __launch_bounds__(NTHREADS, 2) phase_kernel(Params P_) {
    KARG
    int kind, l, g; phase_decode(P_.lo, kind, l, g);
    run_phase<KIND>(P, l, g);
}
#endif

extern "C" void kernel_launch(void* const* d_in, const int* in_sizes, int n_in, void* d_out, int out_size, void* d_ws, size_t ws_size, hipStream_t stream) {
    static int grid = 0;
    if (grid == 0) {
        if (n_in != 29 || (size_t)out_size != O_END || ws_size < WS_END) { fprintf(stderr, "kernel_launch: unexpected shapes n_in %d out %d ws %zu\n", n_in, out_size, ws_size); grid = -1; return; }
        int dev = 0, cus = 0;
        (void)hipGetDevice(&dev); (void)hipDeviceGetAttribute(&cus, hipDeviceAttributeMultiprocessorCount, dev);
#if MK_SINGLE
        (void)hipFuncSetAttribute((const void*)fwd_kernel, hipFuncAttributeMaxDynamicSharedMemorySize, LDS_BYTES);
#else
#define SETATTR(k) (void)hipFuncSetAttribute((const void*)phase_kernel<k>, hipFuncAttributeMaxDynamicSharedMemorySize, LDS_BYTES);
        SETATTR(0) SETATTR(1) SETATTR(2) SETATTR(3) SETATTR(4) SETATTR(5) SETATTR(6) SETATTR(7) SETATTR(8) SETATTR(9) SETATTR(10) SETATTR(11)
#endif
        (void)hipGetLastError();
        grid = cus > 0 ? cus : 256;
    }
    if (grid < 0) return;
    Params p{};
    for (int i = 0; i < 29; ++i) p.in[i] = (const float*)d_in[i];
    p.out = (float*)d_out; p.ws = (unsigned char*)d_ws;
#if MK_SINGLE
    (void)hipMemsetAsync((unsigned char*)d_ws + WS_BAR, 0, 16384, stream);
    p.lo = 0; p.hi = NPHASE;
    void* args[] = {&p};
    hipError_t e = hipLaunchCooperativeKernel((const void*)fwd_kernel, dim3(grid), dim3(NTHREADS), args, LDS_BYTES, stream);
    if (e != hipSuccess) fprintf(stderr, "cooperative launch failed: %s (grid %d)\n", hipGetErrorString(e), grid);
#else
    for (int ph = 0; ph < NPHASE; ++ph) {
        int kind = 0, l = 0, g = 0;
        if (ph == 0) kind = 0; else if (ph == NPHASE - 1) kind = 11;
        else { const int q = ph - 1; l = q / 25; const int r = q % 25; if (r == 0) kind = 1; else if (r == 1) kind = 2; else if (r >= 22) kind = 8 + (r - 22); else { g = (r - 2) / 5; kind = 3 + (r - 2) % 5; } }
        (void)l; (void)g;
        p.lo = ph; p.hi = ph + 1;
        switch (kind) {
#define LAUNCH(k) case k: hipLaunchKernelGGL(phase_kernel<k>, dim3(grid), dim3(NTHREADS), LDS_BYTES, stream, p); break;
        LAUNCH(0) LAUNCH(1) LAUNCH(2) LAUNCH(3) LAUNCH(4) LAUNCH(5) LAUNCH(6) LAUNCH(7) LAUNCH(8) LAUNCH(9) LAUNCH(10) default: hipLaunchKernelGGL(phase_kernel<11>, dim3(grid), dim3(NTHREADS), LDS_BYTES, stream, p); break;
        }
    }
#endif
}
```
